# Optimizing an MI355X kernel written in HIP

```python
import math
import jax, jax.numpy as jnp
from jax import lax
import numpy as np

D_MODEL = 1024
BATCH = 16
SEQ = 4096
DEPTH = 4

GRID_W = 64
CTX_LEN = 256
N_MIXERS = 3
CHUNK = 128
EPS = 1e-6
CM_WIDTH = 2 * D_MODEL
CM_GROUPS = 8
LRU_WIDTH = D_MODEL
LRU_HEADS = 4
LRU_BLOCK = LRU_WIDTH // LRU_HEADS
LRU_CONV = 4
LRU_PAD = (2, 1)
LRU_C = 8.0
MLSTM_HEADS = 4
MLSTM_QK = D_MODEL // 2
MLSTM_V = D_MODEL
MLSTM_DK = MLSTM_QK // MLSTM_HEADS
MLSTM_DV = MLSTM_V // MLSTM_HEADS
FFN_HIDDEN = (8 * D_MODEL // 3) // 128 * 128
FFN_CONV = 3
N_CM = (DEPTH + 2) // 3
N_LRU = (DEPTH + 1) // 3
N_ML = DEPTH // 3

kernel_name = "hybrid_chunkmlp_rglru_mlstm_prefix_dit"


def rms_norm(x, g):
    xf = x.astype(jnp.float32)
    y = xf * lax.rsqrt(jnp.mean(xf * xf, axis=-1, keepdims=True) + EPS)
    return (y * g.astype(jnp.float32)).astype(x.dtype)


def layer_norm(x, g, b):
    xf = x.astype(jnp.float32)
    mu = jnp.mean(xf, axis=-1, keepdims=True)
    var = jnp.mean(jnp.square(xf - mu), axis=-1, keepdims=True)
    y = (xf - mu) * lax.rsqrt(var + EPS)
    return (y * g.astype(jnp.float32) + b.astype(jnp.float32)).astype(x.dtype)


def modulate(h, shift, scale):
    return h * (1.0 + scale) + shift


def dwconv1d(x, w, pad):
    return lax.conv_general_dilated(x, w[:, None, :].astype(x.dtype), (1,), [pad],
                                    dimension_numbers=('NWC', 'WIO', 'NWC'),
                                    feature_group_count=x.shape[-1])


def dwconv2d(x, w):
    return lax.conv_general_dilated(x, w[:, :, None, :].astype(x.dtype), (1, 1), [(1, 1), (1, 1)],
                                    dimension_numbers=('NHWC', 'HWIO', 'NHWC'),
                                    feature_group_count=x.shape[-1])


def chunk_mlp(h, w_in, b_in, v_g, v_b, w_s, b_s, w_out):
    bsz, t, _ = h.shape
    z = jax.nn.gelu(h @ w_in + b_in)
    u, v = jnp.split(z, 2, axis=-1)
    v = layer_norm(v, v_g, v_b)
    v = v.reshape(bsz, t // CHUNK, CHUNK, CM_GROUPS, CM_WIDTH // CM_GROUPS)
    s = jnp.einsum('gpq,bnqgc->bnpgc', w_s, v) + jnp.transpose(b_s)[:, :, None]
    return (u * s.reshape(bsz, t, CM_WIDTH)) @ w_out


def _linear_combine(e1, e2):
    a1, b1 = e1
    a2, b2 = e2
    return a1 * a2, a2 * b1 + b2


def rglru_scan(xr, w_rg, b_rg, w_ig, b_ig, lam, h0):
    bsz, t, w = xr.shape
    xh = xr.reshape(bsz, t, LRU_HEADS, LRU_BLOCK)
    r = jax.nn.sigmoid(jnp.einsum('bthi,hij->bthj', xh, w_rg).reshape(bsz, t, w) + b_rg)
    i = jax.nn.sigmoid(jnp.einsum('bthi,hij->bthj', xh, w_ig).reshape(bsz, t, w) + b_ig)
    log_a = -LRU_C * r * jax.nn.softplus(-lam)
    a = jnp.exp(log_a)
    b = jnp.sqrt(-jnp.expm1(2.0 * log_a)) * (i * xr)
    b = b.at[:, 0].add(a[:, 0] * h0)
    _, hs = lax.associative_scan(_linear_combine, (a, b), axis=1)
    return hs, hs[:, -1]


def lru_mixer(hc, hl, w_in, conv_w, conv_b, w_rg, b_rg, w_ig, b_ig, lam, w_out, ctx_out):
    def branches(h):
        y, xr = jnp.split(h @ w_in, 2, axis=-1)
        xr = dwconv1d(xr, conv_w, LRU_PAD) + conv_b
        return jax.nn.gelu(y), xr.astype(jnp.float32)

    yc, xc = branches(hc)
    yl, xl = branches(hl)
    zero = jnp.zeros((hl.shape[0], LRU_WIDTH), jnp.float32)

    def direction(d, xc_d, xl_d):
        p = (w_rg[d], b_rg[d], w_ig[d], b_ig[d], lam[d])
        hc_d, s_ctx = rglru_scan(xc_d, *p, zero)
        hl_d, _ = rglru_scan(xl_d, *p, s_ctx)
        return hc_d, hl_d

    hcf, hlf = direction(0, xc, xl)
    hcb, hlb = direction(1, jnp.flip(xc, 1), jnp.flip(xl, 1))
    ol = ((hlf + jnp.flip(hlb, 1)).astype(hl.dtype) * yl) @ w_out
    oc = ((hcf + jnp.flip(hcb, 1)).astype(hc.dtype) * yc) @ w_out if ctx_out else None
    return oc, ol


def mlstm_chunked(q, k, v, ig, lf, state):
    bsz, nh, t, _ = q.shape
    dv = v.shape[-1]
    nc = t // CHUNK

    def to_chunks(a):
        return jnp.moveaxis(a.reshape(bsz, nh, nc, CHUNK, *a.shape[3:]), 2, 0)

    causal = jnp.tril(jnp.ones((CHUNK, CHUNK), bool))

    def step(carry, xs):
        C, n, m = carry
        qc, kc, vc, ic, fc = xs
        b = jnp.cumsum(fc, axis=-1)
        dlog = jnp.where(causal, b[..., :, None] - b[..., None, :] + ic[..., None, :], -jnp.inf)
        inter = b + m[..., None]
        m_t = jnp.maximum(inter, jnp.max(dlog, axis=-1))
        dw = jnp.exp(dlog - m_t[..., None])
        iw = jnp.exp(inter - m_t)
        s = jnp.einsum('bhtd,bhsd->bhts', qc, kc) * dw
        num = iw[..., None] * jnp.einsum('bhtd,bhde->bhte', qc, C) + jnp.einsum('bhts,bhse->bhte', s, vc)
        den = iw * jnp.einsum('bhtd,bhd->bht', qc, n) + jnp.sum(s, axis=-1)
        h = num / jnp.maximum(jnp.abs(den), jnp.exp(-m_t))[..., None]
        b_end = b[..., -1]
        wlog = b_end[..., None] - b + ic
        m_new = jnp.maximum(b_end + m, jnp.max(wlog, axis=-1))
        decay = jnp.exp(b_end + m - m_new)
        w = jnp.exp(wlog - m_new[..., None])
        C = decay[..., None, None] * C + jnp.einsum('bhs,bhsd,bhse->bhde', w, kc, vc)
        n = decay[..., None] * n + jnp.einsum('bhs,bhsd->bhd', w, kc)
        return (C, n, m_new), h

    state, hs = lax.scan(step, state, (to_chunks(q), to_chunks(k), to_chunks(v), to_chunks(ig), to_chunks(lf)))
    return jnp.moveaxis(hs, 0, 2).reshape(bsz, nh, t, dv), state


def mlstm_mixer(hc, hl, w_in, b_gate, norm_g, w_out, ctx_out):
    splits = [MLSTM_QK, 2 * MLSTM_QK, 2 * MLSTM_QK + MLSTM_V, 2 * MLSTM_QK + 2 * MLSTM_V]

    def project(h):
        bsz, t, _ = h.shape
        q, k, v, o, g = jnp.split(h @ w_in, splits, axis=-1)

        def heads(a, d):
            return jnp.transpose(a.reshape(bsz, t, MLSTM_HEADS, d), (0, 2, 1, 3)).astype(jnp.float32)

        g = g.reshape(bsz, t, 2, 2, MLSTM_HEADS).astype(jnp.float32) + b_gate.astype(jnp.float32)
        g = jnp.transpose(g, (2, 3, 0, 4, 1))
        return heads(q, MLSTM_DK) * MLSTM_DK ** -0.5, heads(k, MLSTM_DK), heads(v, MLSTM_DV), o, g

    qc, kc, vc, oc_g, gc = project(hc)
    ql, kl, vl, ol_g, gl = project(hl)
    bsz = hl.shape[0]
    zero = (jnp.zeros((bsz, MLSTM_HEADS, MLSTM_DK, MLSTM_DV), jnp.float32),
            jnp.zeros((bsz, MLSTM_HEADS, MLSTM_DK), jnp.float32),
            jnp.zeros((bsz, MLSTM_HEADS), jnp.float32))

    def run(d, rev):
        f = (lambda a: jnp.flip(a, axis=2)) if rev else (lambda a: a)
        hc_d, st = mlstm_chunked(f(qc), f(kc), f(vc), f(gc[d, 0]), f(jax.nn.log_sigmoid(gc[d, 1])), zero)
        hl_d, _ = mlstm_chunked(f(ql), f(kl), f(vl), f(gl[d, 0]), f(jax.nn.log_sigmoid(gl[d, 1])), st)
        return f(hc_d), f(hl_d)

    hcf, hlf = run(0, False)
    hcb, hlb = run(1, True)

    def readout(hf, hb, o, dtype):
        h = hf + hb
        h = h * lax.rsqrt(jnp.mean(h * h, axis=-1, keepdims=True) + EPS)
        b_, _, t, _ = h.shape
        h = (jnp.transpose(h, (0, 2, 1, 3)).reshape(b_, t, MLSTM_V) * norm_g).astype(dtype)
        return (jax.nn.sigmoid(o) * h) @ w_out

    ol = readout(hlf, hlb, ol_g, hl.dtype)
    oc = readout(hcf, hcb, oc_g, hc.dtype) if ctx_out else None
    return oc, ol


def conv_ffn(h, w_up, conv_w, conv_b, w_down, on_grid):
    bsz, t, _ = h.shape
    z = h @ w_up
    if on_grid:
        rows = t // GRID_W
        z = dwconv2d(z.reshape(bsz, rows, GRID_W, z.shape[-1]), conv_w).reshape(bsz, t, z.shape[-1])
    else:
        z = dwconv1d(z, conv_w[FFN_CONV // 2], (1, 1))
    g, u = jnp.split(z + conv_b, 2, axis=-1)
    return (jax.nn.silu(g) * u) @ w_down


def setup_inputs(seed: int = 0) -> dict:
    key = jax.random.key(seed)
    ks = iter(jax.random.split(key, 48))
    D = D_MODEL
    F = FFN_HIDDEN

    def nrm(shape, scale):
        return jax.random.normal(next(ks), shape, jnp.float32) * scale

    def gain(shape):
        return 1.0 + nrm(shape, 0.02)

    x = nrm((BATCH, SEQ, D), 1.0)
    c = nrm((BATCH, D), 1.0)
    ctx = nrm((BATCH, CTX_LEN, D), 1.0)
    c_ctx = nrm((D,), 1.0)
    norm1_g = gain((DEPTH, D))
    norm2_g = gain((DEPTH, D))
    mod_w = nrm((DEPTH, D, 6 * D), 0.5 * D ** -0.5)
    mod_b = nrm((DEPTH, 6 * D), 0.02)
    ffn_w_up = nrm((DEPTH, D, 2 * F), D ** -0.5)
    ffn_conv_w = nrm((DEPTH, FFN_CONV, FFN_CONV, 2 * F), 1.0 / FFN_CONV)
    ffn_conv_b = nrm((DEPTH, 2 * F), 0.02)
    ffn_w_down = nrm((DEPTH, F, D), F ** -0.5)
    cm_w_in = nrm((N_CM, D, 2 * CM_WIDTH), D ** -0.5)
    cm_b_in = nrm((N_CM, 2 * CM_WIDTH), 0.02)
    cm_v_g = gain((N_CM, CM_WIDTH))
    cm_v_b = nrm((N_CM, CM_WIDTH), 0.02)
    cm_w_s = nrm((N_CM, CM_GROUPS, CHUNK, CHUNK), CHUNK ** -0.5)
    cm_b_s = 1.0 + nrm((N_CM, CM_GROUPS, CHUNK), 0.02)
    cm_w_out = nrm((N_CM, CM_WIDTH, D), CM_WIDTH ** -0.5)
    lru_w_in = nrm((N_LRU, D, 2 * LRU_WIDTH), D ** -0.5)
    lru_conv_w = nrm((N_LRU, LRU_CONV, LRU_WIDTH), LRU_CONV ** -0.5)
    lru_conv_b = nrm((N_LRU, LRU_WIDTH), 0.02)
    lru_w_rg = nrm((N_LRU, 2, LRU_HEADS, LRU_BLOCK, LRU_BLOCK), LRU_BLOCK ** -0.5)
    lru_b_rg = nrm((N_LRU, 2, LRU_WIDTH), 0.02)
    lru_w_ig = nrm((N_LRU, 2, LRU_HEADS, LRU_BLOCK, LRU_BLOCK), LRU_BLOCK ** -0.5)
    lru_b_ig = nrm((N_LRU, 2, LRU_WIDTH), 0.02)
    p = jax.random.uniform(next(ks), (N_LRU, 2, LRU_WIDTH), jnp.float32, 0.9, 0.999)
    lru_lambda = jnp.log(p) - jnp.log1p(-p)
    lru_w_out = nrm((N_LRU, LRU_WIDTH, D), LRU_WIDTH ** -0.5)
    ml_w_in = nrm((N_ML, D, 2 * MLSTM_QK + 2 * MLSTM_V + 4 * MLSTM_HEADS), D ** -0.5)
    ig_b = nrm((N_ML, 2, 1, MLSTM_HEADS), 0.1)
    fg_b = jax.random.uniform(next(ks), (N_ML, 2, 1, MLSTM_HEADS), jnp.float32, 3.0, 6.0)
    ml_b_gate = jnp.concatenate([ig_b, fg_b], axis=2)
    ml_norm_g = gain((N_ML, MLSTM_V))
    ml_w_out = nrm((N_ML, MLSTM_V, D), MLSTM_V ** -0.5)
    final_norm_g = gain((D,))
    return {"x": x, "c": c, "ctx": ctx, "c_ctx": c_ctx,
            "norm1_g": norm1_g, "norm2_g": norm2_g, "mod_w": mod_w, "mod_b": mod_b,
            "ffn_w_up": ffn_w_up, "ffn_conv_w": ffn_conv_w, "ffn_conv_b": ffn_conv_b, "ffn_w_down": ffn_w_down,
            "cm_w_in": cm_w_in, "cm_b_in": cm_b_in, "cm_v_g": cm_v_g, "cm_v_b": cm_v_b,
            "cm_w_s": cm_w_s, "cm_b_s": cm_b_s, "cm_w_out": cm_w_out,
            "lru_w_in": lru_w_in, "lru_conv_w": lru_conv_w, "lru_conv_b": lru_conv_b,
            "lru_w_rg": lru_w_rg, "lru_b_rg": lru_b_rg, "lru_w_ig": lru_w_ig, "lru_b_ig": lru_b_ig,
            "lru_lambda": lru_lambda, "lru_w_out": lru_w_out,
            "ml_w_in": ml_w_in, "ml_b_gate": ml_b_gate, "ml_norm_g": ml_norm_g, "ml_w_out": ml_w_out,
            "final_norm_g": final_norm_g}


def reference(x, c, ctx, c_ctx, norm1_g, norm2_g, mod_w, mod_b,
              ffn_w_up, ffn_conv_w, ffn_conv_b, ffn_w_down,
              cm_w_in, cm_b_in, cm_v_g, cm_v_b, cm_w_s, cm_b_s, cm_w_out,
              lru_w_in, lru_conv_w, lru_conv_b, lru_w_rg, lru_b_rg, lru_w_ig, lru_b_ig,
              lru_lambda, lru_w_out,
              ml_w_in, ml_b_gate, ml_norm_g, ml_w_out, final_norm_g):
    xl = x
    xc = ctx
    cond_lat = jax.nn.silu(c)
    cond_ctx = jax.nn.silu(c_ctx)
    for l in range(DEPTH):
        kind = l % N_MIXERS
        j = l // N_MIXERS
        last = l == DEPTH - 1
        sh1, sc1, g1, sh2, sc2, g2 = jnp.split((cond_lat @ mod_w[l] + mod_b[l])[:, None, :], 6, axis=-1)
        csh1, csc1, cg1, csh2, csc2, cg2 = jnp.split(cond_ctx @ mod_w[l] + mod_b[l], 6, axis=-1)
        hl = modulate(rms_norm(xl, norm1_g[l]), sh1, sc1)
        if kind == 0:
            cm_args = (cm_w_in[j], cm_b_in[j], cm_v_g[j], cm_v_b[j], cm_w_s[j], cm_b_s[j], cm_w_out[j])
            ol = chunk_mlp(hl, *cm_args)
            oc = None if last else chunk_mlp(modulate(rms_norm(xc, norm1_g[l]), csh1, csc1), *cm_args)
        elif kind == 1:
            hc = modulate(rms_norm(xc, norm1_g[l]), csh1, csc1)
            oc, ol = lru_mixer(hc, hl, lru_w_in[j], lru_conv_w[j], lru_conv_b[j], lru_w_rg[j], lru_b_rg[j],
                               lru_w_ig[j], lru_b_ig[j], lru_lambda[j], lru_w_out[j], not last)
        else:
            hc = modulate(rms_norm(xc, norm1_g[l]), csh1, csc1)
            oc, ol = mlstm_mixer(hc, hl, ml_w_in[j], ml_b_gate[j], ml_norm_g[j], ml_w_out[j], not last)
        ffn_args = (ffn_w_up[l], ffn_conv_w[l], ffn_conv_b[l], ffn_w_down[l])
        xl = xl + g1 * ol
        xl = xl + g2 * conv_ffn(modulate(rms_norm(xl, norm2_g[l]), sh2, sc2), *ffn_args, True)
        if not last:
            xc = xc + cg1 * oc
            xc = xc + cg2 * conv_ffn(modulate(rms_norm(xc, norm2_g[l]), csh2, csc2), *ffn_args, False)
    return rms_norm(xl, final_norm_g)
```

```cpp
#include <hip/hip_runtime.h>
#include <hip/hip_cooperative_groups.h>
#include <cstdio>
namespace cg = cooperative_groups;

#define LAS __attribute__((address_space(3)))
typedef unsigned short u16;
typedef short bf16x8 __attribute__((ext_vector_type(8)));
typedef float f32x4 __attribute__((ext_vector_type(4)));
typedef float f32x2 __attribute__((ext_vector_type(2)));
typedef unsigned u32x4 __attribute__((ext_vector_type(4)));
typedef unsigned u32x2 __attribute__((ext_vector_type(2)));

constexpr int DM = 1024, NB = 16, SEQ = 4096, CTXL = 256;
constexpr int ML = NB * SEQ, MC = NB * CTXL, MT = ML + MC;
constexpr int FH = 2688, F2 = 5376;
constexpr int LDS_BYTES = 147456;

constexpr size_t SZ_FFN_UP_T = (size_t)F2 * 1024 * 2, SZ_FFN_DN_T = (size_t)1024 * FH * 2;
constexpr size_t WS_FFN_UP_T = 0;
constexpr size_t WS_FFN_DN_T = WS_FFN_UP_T + 4 * SZ_FFN_UP_T;
constexpr size_t WS_CM_IN_T = WS_FFN_DN_T + 4 * SZ_FFN_DN_T;
constexpr size_t WS_CM_OUT_T = WS_CM_IN_T + 2 * (size_t)4096 * 1024 * 2;
constexpr size_t WS_LRU_IN_T = WS_CM_OUT_T + 2 * (size_t)1024 * 2048 * 2;
constexpr size_t WS_LRU_G_T = WS_LRU_IN_T + (size_t)2048 * 1024 * 2;
constexpr size_t WS_LRU_OUT_T = WS_LRU_G_T + (size_t)4 * 1024 * 256 * 2;
constexpr size_t WS_ML_IN_T = WS_LRU_OUT_T + (size_t)1024 * 1024 * 2;
constexpr size_t WS_ML_OUT_T = WS_ML_IN_T + (size_t)3328 * 1024 * 2;
constexpr size_t WS_XC = WS_ML_OUT_T + (size_t)1024 * 1024 * 2;
constexpr size_t WS_MOD = WS_XC + (size_t)MC * 1024 * 4;
constexpr size_t WS_SEG = WS_MOD + (size_t)4 * 17 * 6144 * 4;
constexpr size_t WS_CARRY = WS_SEG + (size_t)2 * 272 * 1024 * 2 * 4;
constexpr size_t WS_SP8 = WS_CARRY + (size_t)2 * 272 * 1024 * 4;
constexpr size_t WS_ACT = WS_SP8 + 8192;
constexpr size_t SLOT = (size_t)MT * 1024 * 2;
constexpr size_t WS_END = WS_ACT + SLOT + (size_t)MT * 2816 * 2 + (size_t)MT * FH * 2;

struct Params {
    const float *x, *c, *ctx, *c_ctx, *norm1_g, *norm2_g, *mod_w, *mod_b, *ffn_w_up, *ffn_conv_w, *ffn_conv_b, *ffn_w_down,
        *cm_w_in, *cm_b_in, *cm_v_g, *cm_v_b, *cm_w_s, *cm_b_s, *cm_w_out, *lru_w_in, *lru_conv_w, *lru_conv_b, *lru_w_rg, *lru_b_rg,
        *lru_w_ig, *lru_b_ig, *lru_lambda, *lru_w_out, *ml_w_in, *ml_b_gate, *ml_norm_g, *ml_w_out, *final_norm_g;
    float* out; unsigned char* ws;
};

__device__ __forceinline__ unsigned cvt_pk_bf16(float lo, float hi) { unsigned r; asm volatile("v_cvt_pk_bf16_f32 %0, %1, %2" : "=v"(r) : "v"(lo), "v"(hi)); return r; }
__device__ __forceinline__ float bf_lo(unsigned w) { return __uint_as_float(w << 16); }
__device__ __forceinline__ float bf_hi(unsigned w) { return __uint_as_float(w & 0xffff0000u); }
__device__ __forceinline__ float bf2f(u16 b) { return __uint_as_float(((unsigned)b) << 16); }
__device__ __forceinline__ u16 f2bf(float f) { return (u16)(cvt_pk_bf16(f, 0.f) & 0xffffu); }
__device__ __forceinline__ float wave_sum(float v) {
#pragma unroll
    for (int o = 1; o < 64; o <<= 1) v += __shfl_xor(v, o);
    return v;
}
__device__ __forceinline__ float sigmoidf_(float x) { return 1.0f / (1.0f + __expf(-x)); }
__device__ __forceinline__ float gelu_tanh(float x) { const float t = x * (1.5957691216f + 0.0713548163f * x * x); return x / (1.0f + __expf(-t)); }
__device__ __forceinline__ float siluf_(float x) { return x / (1.0f + __expf(-x)); }
__device__ __forceinline__ void unpack8(const u32x4 w, float (&f)[8]) {
    f[0] = bf_lo(w.x); f[1] = bf_hi(w.x); f[2] = bf_lo(w.y); f[3] = bf_hi(w.y); f[4] = bf_lo(w.z); f[5] = bf_hi(w.z); f[6] = bf_lo(w.w); f[7] = bf_hi(w.w);
}
__device__ __forceinline__ u32x4 pack8(const float (&f)[8]) {
    u32x4 w; w.x = cvt_pk_bf16(f[0], f[1]); w.y = cvt_pk_bf16(f[2], f[3]); w.z = cvt_pk_bf16(f[4], f[5]); w.w = cvt_pk_bf16(f[6], f[7]); return w;
}
#define BLOCK_SYNC() __syncthreads()
__device__ __forceinline__ int opaque_tid() { int t = threadIdx.x; asm volatile("" : "+v"(t)); return t; }

namespace g8 {
constexpr int BM = 256, BK = 64, HALF = 128, HTB = HALF * BK * 2, STAGE_BYTES = 8 * HTB, NXCD = 8, WGM = 8;
__device__ __forceinline__ int lds_byte(int r, int c) { const int st = (r >> 4) * 2 + (c >> 5), rr = r & 15, cc = c & 31, ob = rr * 64 + cc * 2; return st * 1024 + (ob ^ (((ob >> 9) & 1) << 5)); }
__device__ __forceinline__ void stage_rc(int b, int& R, int& C) { const int st = b / 1024, sb = b % 1024, swz = sb ^ (((sb >> 9) & 1) << 5); R = (st >> 1) * 16 + swz / 64; C = (st & 1) * 32 + (swz % 64) / 2; }
__device__ __forceinline__ int perm32(int rho) { const int n = rho >> 4, i = rho & 15; return 8 * (i >> 2) + 4 * n + (i & 3); }

struct Unit { int pm, pn, z; };
struct Desc { const u16* A; const u16* Bt; int lda, ldb, K, nM, nN, nZ, pm0, pn0; size_t zA, zB; };

__device__ __forceinline__ bool next_unit(const Desc& g, int i, Unit& u) {
    const int nwg = g.nM * g.nN; const long L = (long)i * gridDim.x + blockIdx.x; if (L >= (long)nwg * g.nZ) return false;
    u.z = (int)(L / nwg); int wgid = (int)(L % nwg);
    { const int q = nwg / NXCD, r = nwg % NXCD, xcd = wgid % NXCD, off = wgid / NXCD; wgid = (xcd < r ? xcd * (q + 1) : r * (q + 1) + (xcd - r) * q) + off; }
    const int nig = WGM * g.nN, gid = wgid / nig, fm = gid * WGM, gsz = (g.nM - fm) < WGM ? (g.nM - fm) : WGM;
    u.pm = g.pm0 + fm + ((wgid % nig) % gsz); u.pn = g.pn0 + (wgid % nig) / gsz; return true;
}

template <class Epi>
__device__ __forceinline__ void gemm_phase(LAS unsigned char* lds, const Desc g, const Epi& E) {
    const int tid = opaque_tid(), wid = __builtin_amdgcn_readfirstlane(tid >> 6), lane = tid & 63, wr = wid >> 2, wc = wid & 3, fr = lane & 15, fq = lane >> 4;
    const int K = g.K, nt = K / BK;
    unsigned voffA[2], voffB[2];
#pragma unroll
    for (int i = 0; i < 2; ++i) { int R, C; stage_rc(tid * 16 + i * 8192, R, C); const int Rb = Epi::PERM ? ((R & ~31) + perm32(R & 31)) : R;
        voffA[i] = (unsigned)(R * g.lda + C) * 2u; voffB[i] = (unsigned)(Rb * g.ldb + C) * 2u; }
    const size_t kstep = (size_t)(BK * 2);
    const size_t hstepA = (size_t)HALF * g.lda * 2, hstepB = (size_t)HALF * g.ldb * 2;
    const size_t tstepA = 2 * hstepA, tstepB = 2 * hstepB;
    const unsigned ldsw = (unsigned)wid * 1024u;
    const int aoff = lds_byte(wr * 64 + fr, fq * 8), boff = lds_byte(wc * 32 + fr, fq * 8);
#define PG8_SA(b, h) (((b) * 2 + (h)) * HTB)
#define PG8_SB(b, h) ((4 + (b) * 2 + (h)) * HTB)
#define PG8_STAGE(bufoff, gbase, voff) do { _Pragma("unroll") for (int _i = 0; _i < 2; ++_i) \
        __builtin_amdgcn_global_load_lds((const unsigned*)((const char*)(gbase) + (voff)[_i]), (LAS unsigned*)(lds + (bufoff) + ldsw + _i * 8192), 16, 0, 0); } while (0)
#define PG8_LDA(dst, b, h) do { _Pragma("unroll") for (int m = 0; m < 4; ++m) _Pragma("unroll") for (int k = 0; k < 2; ++k) dst[m][k] = *(const LAS bf16x8*)(lds + PG8_SA(b, h) + aoff + m * 2048 + k * 1024); } while (0)
#define PG8_LDB(dst, b, h) do { _Pragma("unroll") for (int n = 0; n < 2; ++n) _Pragma("unroll") for (int k = 0; k < 2; ++k) dst[n][k] = *(const LAS bf16x8*)(lds + PG8_SB(b, h) + boff + n * 2048 + k * 1024); } while (0)
#define PG8_MMA(ai, bj, At, Bt) do { __builtin_amdgcn_s_setprio(1); _Pragma("unroll") for (int m = 0; m < 4; ++m) _Pragma("unroll") for (int n = 0; n < 2; ++n) _Pragma("unroll") for (int k = 0; k < 2; ++k) \
        acc[ai][bj][m][n] = __builtin_amdgcn_mfma_f32_16x16x32_bf16(Bt[n][k], At[m][k], acc[ai][bj][m][n], 0, 0, 0); __builtin_amdgcn_s_setprio(0); } while (0)
#define PG8_WAIT_V(n) asm volatile("s_waitcnt vmcnt(" #n ")" ::: "memory")
#define PG8_WAIT_L(n) asm volatile("s_waitcnt lgkmcnt(" #n ")" ::: "memory")
#define PG8_BAR __builtin_amdgcn_s_barrier()
#define PG8_SCHED __builtin_amdgcn_sched_barrier(0)
    Unit cur, nxt; int ui = 0;
    if (!next_unit(g, 0, cur)) return;
    f32x4 acc[2][2][4][2];
#pragma unroll
    for (int a = 0; a < 2; ++a)
#pragma unroll
        for (int b = 0; b < 2; ++b)
#pragma unroll
            for (int m = 0; m < 4; ++m)
#pragma unroll
                for (int n = 0; n < 2; ++n) acc[a][b][m][n] = (f32x4){0.f, 0.f, 0.f, 0.f};
    bf16x8 At[4][2], B0[2][2], B1[2][2];
    const char* cA = (const char*)g.A + ((size_t)cur.z * g.zA) * 2 + (size_t)cur.pm * tstepA;
    const char* cB = (const char*)g.Bt + ((size_t)cur.z * g.zB) * 2 + (size_t)cur.pn * tstepB;
    PG8_STAGE(PG8_SB(0, 0), cB, voffB); PG8_STAGE(PG8_SA(0, 0), cA, voffA); PG8_STAGE(PG8_SB(0, 1), cB + hstepB, voffB); PG8_STAGE(PG8_SA(0, 1), cA + hstepA, voffA);
    if (wr == 1) PG8_BAR;
    PG8_WAIT_V(4); PG8_BAR;
    PG8_STAGE(PG8_SB(1, 0), cB + kstep, voffB); PG8_STAGE(PG8_SA(1, 0), cA + kstep, voffA); PG8_STAGE(PG8_SB(1, 1), cB + hstepB + kstep, voffB);
    PG8_WAIT_V(6); PG8_BAR;
    for (;;) {
        const bool has_next = next_unit(g, ui + 1, nxt);
        const char* nA = has_next ? (const char*)g.A + ((size_t)nxt.z * g.zA) * 2 + (size_t)nxt.pm * tstepA : cA;
        const char* nB = has_next ? (const char*)g.Bt + ((size_t)nxt.z * g.zB) * 2 + (size_t)nxt.pn * tstepB : cB;
        for (int t = 0; t < nt; t += 2) {
            const bool last = (t == nt - 2);
            const char* a1 = cA + (size_t)(t + 1) * kstep;
            const char* a2 = last ? nA : cA + (size_t)(t + 2) * kstep; const char* b2 = last ? nB : cB + (size_t)(t + 2) * kstep;
            const char* a3 = a2 + kstep; const char* b3 = b2 + kstep;
            PG8_LDB(B0, 0, 0); PG8_SCHED; PG8_LDA(At, 0, 0); PG8_STAGE(PG8_SA(1, 1), a1 + hstepA, voffA);
            PG8_WAIT_L(8); PG8_BAR; PG8_WAIT_L(0); PG8_MMA(0, 0, At, B0); PG8_BAR; PG8_SCHED;
            PG8_LDB(B1, 0, 1); PG8_STAGE(PG8_SB(0, 0), b2, voffB);
            PG8_BAR; PG8_WAIT_L(0); PG8_MMA(0, 1, At, B1); PG8_BAR;
            PG8_LDA(At, 0, 1); PG8_STAGE(PG8_SA(0, 0), a2, voffA);
            PG8_BAR; PG8_WAIT_L(0); PG8_MMA(1, 0, At, B0); PG8_BAR; PG8_SCHED;
            PG8_STAGE(PG8_SB(0, 1), b2 + hstepB, voffB);
            PG8_WAIT_V(6); PG8_BAR; PG8_MMA(1, 1, At, B1); PG8_BAR;
            PG8_LDB(B0, 1, 0); PG8_SCHED; PG8_LDA(At, 1, 0); PG8_STAGE(PG8_SA(0, 1), a2 + hstepA, voffA);
            PG8_WAIT_L(8); PG8_BAR; PG8_WAIT_L(0); PG8_MMA(0, 0, At, B0); PG8_BAR; PG8_SCHED;
            PG8_LDB(B1, 1, 1); PG8_STAGE(PG8_SB(1, 0), b3, voffB);
            PG8_BAR; PG8_WAIT_L(0); PG8_MMA(0, 1, At, B1); PG8_BAR;
            PG8_LDA(At, 1, 1); PG8_STAGE(PG8_SA(1, 0), a3, voffA);
            PG8_BAR; PG8_WAIT_L(0); PG8_MMA(1, 0, At, B0); PG8_BAR; PG8_SCHED;
            PG8_STAGE(PG8_SB(1, 1), b3 + hstepB, voffB);
            PG8_WAIT_V(6); PG8_BAR; PG8_MMA(1, 1, At, B1); PG8_BAR;
        }
        E(acc, cur, wr, wc, fr, fq);
        if (!has_next) break;
#pragma unroll
        for (int a = 0; a < 2; ++a)
#pragma unroll
            for (int b = 0; b < 2; ++b)
#pragma unroll
                for (int m = 0; m < 4; ++m)
#pragma unroll
                    for (int n = 0; n < 2; ++n) acc[a][b][m][n] = (f32x4){0.f, 0.f, 0.f, 0.f};
        cur = nxt; cA = nA; cB = nB; ++ui;
    }
    PG8_WAIT_V(0);
    if (wr == 0) PG8_BAR;
    PG8_BAR;
#undef PG8_SA
#undef PG8_SB
#undef PG8_STAGE
#undef PG8_LDA
#undef PG8_LDB
#undef PG8_MMA
#undef PG8_WAIT_V
#undef PG8_WAIT_L
#undef PG8_BAR
#undef PG8_SCHED
}
}

enum { M_BF16 = 0, M_CMIN = 1, M_RES = 2, M_LRUIN = 3, M_LRUG = 4, M_MLIN = 5 };
struct EP {
    u16 *o0, *o1, *o2, *o3; float* f0;
    const float *xsl, *xsc; float *xdl, *xdc;
    const float *gate, *bias, *q0, *q1, *q2; const u16* bsrc;
    int ldc, pn0;
};
template <int MODE> struct Epi {
    static constexpr bool PERM = (MODE != M_RES);
    EP p;
    __device__ __forceinline__ void operator()(const f32x4 (&acc)[2][2][4][2], const g8::Unit& u, int wr, int wc, int fr, int fq) const {
        const int row0 = u.pm * 256 + wr * 64 + fr;
        if constexpr (MODE == M_RES) {
            const int col0 = u.pn * 256 + wc * 32 + 4 * fq;
            const bool lat = u.pm < 256; const int mb = lat ? (u.pm >> 4) : 16;
            const float* gp = p.gate + (size_t)mb * 6144 + col0;
            f32x4 gv[2][2];
#pragma unroll
            for (int bj = 0; bj < 2; ++bj)
#pragma unroll
                for (int n = 0; n < 2; ++n) gv[bj][n] = *(const f32x4*)(gp + bj * 128 + n * 16);
            const float* xs = lat ? p.xsl : p.xsc; float* xd = lat ? p.xdl : p.xdc; const int rbase = lat ? row0 : row0 - ML;
#pragma unroll
            for (int ai = 0; ai < 2; ++ai)
#pragma unroll
                for (int m = 0; m < 4; ++m) { const size_t off = (size_t)(rbase + ai * 128 + m * 16) * 1024 + col0;
#pragma unroll
                    for (int bj = 0; bj < 2; ++bj)
#pragma unroll
                        for (int n = 0; n < 2; ++n) { const f32x4 xv = *(const f32x4*)(xs + off + bj * 128 + n * 16); *(f32x4*)(xd + off + bj * 128 + n * 16) = xv + gv[bj][n] * acc[ai][bj][m][n]; } }
        } else if constexpr (MODE == M_BF16) {
            const int col0 = (u.pn - p.pn0) * 256 + wc * 32 + 8 * fq;
#pragma unroll
            for (int ai = 0; ai < 2; ++ai)
#pragma unroll
                for (int m = 0; m < 4; ++m) { u16* rp = p.o0 + (size_t)(row0 + ai * 128 + m * 16) * p.ldc + col0;
#pragma unroll
                    for (int bj = 0; bj < 2; ++bj) { const f32x4 v0 = acc[ai][bj][m][0], v1 = acc[ai][bj][m][1];
                        u32x4 w; w.x = cvt_pk_bf16(v0[0], v0[1]); w.y = cvt_pk_bf16(v0[2], v0[3]); w.z = cvt_pk_bf16(v1[0], v1[1]); w.w = cvt_pk_bf16(v1[2], v1[3]);
                        *(u32x4*)(rp + bj * 128) = w; } }
        } else if constexpr (MODE == M_CMIN) {
            const int colg = u.pn * 256 + wc * 32 + 8 * fq;
            const bool isv = u.pn >= 8; u16* base = isv ? p.o1 : p.o0; const int colt = colg - (isv ? 2048 : 0);
            f32x4 bv[2][2];
#pragma unroll
            for (int bj = 0; bj < 2; ++bj)
#pragma unroll
                for (int n = 0; n < 2; ++n) bv[bj][n] = *(const f32x4*)(p.bias + colg + bj * 128 + 4 * n);
#pragma unroll
            for (int ai = 0; ai < 2; ++ai)
#pragma unroll
                for (int m = 0; m < 4; ++m) { const int row = row0 + ai * 128 + m * 16; u16* rp = base + (size_t)row * 2048 + colt; float s = 0.f, ss = 0.f;
#pragma unroll
                    for (int bj = 0; bj < 2; ++bj) { f32x4 v0 = acc[ai][bj][m][0] + bv[bj][0], v1 = acc[ai][bj][m][1] + bv[bj][1];
#pragma unroll
                        for (int e = 0; e < 4; ++e) { v0[e] = gelu_tanh(v0[e]); v1[e] = gelu_tanh(v1[e]); s += v0[e] + v1[e]; ss += v0[e] * v0[e] + v1[e] * v1[e]; }
                        u32x4 w; w.x = cvt_pk_bf16(v0[0], v0[1]); w.y = cvt_pk_bf16(v0[2], v0[3]); w.z = cvt_pk_bf16(v1[0], v1[1]); w.w = cvt_pk_bf16(v1[2], v1[3]);
                        *(u32x4*)(rp + bj * 128) = w; }
                    if (isv) { s += __shfl_xor(s, 16); s += __shfl_xor(s, 32); ss += __shfl_xor(ss, 16); ss += __shfl_xor(ss, 32);
                        if (fq == 0) *(f32x2*)(p.f0 + ((size_t)row * 32 + (u.pn - 8) * 4 + wc) * 2) = (f32x2){s, ss}; } }
        } else if constexpr (MODE == M_LRUIN) {
            const int colg = u.pn * 256 + wc * 32 + 8 * fq;
            const bool isx = u.pn >= 4; u16* base = isx ? p.o1 : p.o0; const int colt = colg - (isx ? 1024 : 0);
#pragma unroll
            for (int ai = 0; ai < 2; ++ai)
#pragma unroll
                for (int m = 0; m < 4; ++m) { u16* rp = base + (size_t)(row0 + ai * 128 + m * 16) * 1024 + colt;
#pragma unroll
                    for (int bj = 0; bj < 2; ++bj) { f32x4 v0 = acc[ai][bj][m][0], v1 = acc[ai][bj][m][1];
                        if (!isx) {
#pragma unroll
                            for (int e = 0; e < 4; ++e) { v0[e] = gelu_tanh(v0[e]); v1[e] = gelu_tanh(v1[e]); } }
                        u32x4 w; w.x = cvt_pk_bf16(v0[0], v0[1]); w.y = cvt_pk_bf16(v0[2], v0[3]); w.z = cvt_pk_bf16(v1[0], v1[1]); w.w = cvt_pk_bf16(v1[2], v1[3]);
                        *(u32x4*)(rp + bj * 128) = w; } }
        } else if constexpr (MODE == M_LRUG) {
            const int h = u.z, d = u.pn >> 1, jb = u.pn & 1;
            const int ch = h * 256 + jb * 128 + wc * 32 + 8 * fq;
            u16* la = d ? p.o2 : p.o0; u16* bo = d ? p.o3 : p.o1;
#pragma unroll
            for (int n = 0; n < 2; ++n) {
                const int c4 = ch + 4 * n;
                const f32x4 brg = *(const f32x4*)(p.q0 + d * 1024 + c4), big = *(const f32x4*)(p.q1 + d * 1024 + c4), sp4 = *(const f32x4*)(p.q2 + d * 1024 + c4);
#pragma unroll
                for (int ai = 0; ai < 2; ++ai)
#pragma unroll
                    for (int m = 0; m < 4; ++m) { const size_t off = (size_t)(row0 + ai * 128 + m * 16) * 1024 + c4;
                        const u32x2 xr = *(const u32x2*)(p.bsrc + off); const float xv[4] = {bf_lo(xr.x), bf_hi(xr.x), bf_lo(xr.y), bf_hi(xr.y)};
                        float lo[4], bb[4];
#pragma unroll
                        for (int e = 0; e < 4; ++e) { const float r = sigmoidf_(acc[ai][0][m][n][e] + brg[e]), ig = sigmoidf_(acc[ai][1][m][n][e] + big[e]);
                            const float lg = -sp4[e] * r; lo[e] = lg; bb[e] = sqrtf(fmaxf(-expm1f(2.0f * lg), 0.f)) * ig * xv[e]; }
                        u32x2 o1; o1.x = cvt_pk_bf16(lo[0], lo[1]); o1.y = cvt_pk_bf16(lo[2], lo[3]); *(u32x2*)(la + off) = o1;
                        u32x2 o2; o2.x = cvt_pk_bf16(bb[0], bb[1]); o2.y = cvt_pk_bf16(bb[2], bb[3]); *(u32x2*)(bo + off) = o2; }
            }
        } else if constexpr (MODE == M_MLIN) {
            const int colg = u.pn * 256 + wc * 32 + 8 * fq;
            const int reg = u.pn < 2 ? 0 : (u.pn < 4 ? 1 : (u.pn < 8 ? 2 : (u.pn < 12 ? 3 : 4)));
            u16* base = reg == 0 ? p.o0 : (reg == 1 ? p.o1 : (reg == 2 ? p.o2 : p.o3));
            const int ld = (reg < 2) ? 512 : 1024; const int colt = colg - (reg == 0 ? 0 : (reg == 1 ? 512 : (reg == 2 ? 1024 : 2048)));
#pragma unroll
            for (int ai = 0; ai < 2; ++ai)
#pragma unroll
                for (int m = 0; m < 4; ++m) { const int row = row0 + ai * 128 + m * 16;
                    if (reg < 4) { u16* rp = base + (size_t)row * ld + colt;
#pragma unroll
                        for (int bj = 0; bj < 2; ++bj) { f32x4 v0 = acc[ai][bj][m][0], v1 = acc[ai][bj][m][1];
                            if (reg == 0) { v0 = v0 * 0.08838834764831845f; v1 = v1 * 0.08838834764831845f; }
                            if (reg == 3) {
#pragma unroll
                                for (int e = 0; e < 4; ++e) { v0[e] = sigmoidf_(v0[e]); v1[e] = sigmoidf_(v1[e]); } }
                            u32x4 w; w.x = cvt_pk_bf16(v0[0], v0[1]); w.y = cvt_pk_bf16(v0[2], v0[3]); w.z = cvt_pk_bf16(v1[0], v1[1]); w.w = cvt_pk_bf16(v1[2], v1[3]);
                            *(u32x4*)(rp + bj * 128) = w; }
                    } else {
                        const int cl = wc * 32 + 8 * fq;
                        if (cl < 16) {
#pragma unroll
                            for (int e = 0; e < 8; ++e) p.f0[(size_t)row * 16 + cl + e] = acc[ai][0][m][e >> 2][e & 3] + p.bias[cl + e]; }
                    } }
        }
    }
};

__device__ __forceinline__ void tr_item(const float* src, int ld, int nvalid, u16* dst, int ldd, LAS float* scr, int lane) {
#pragma unroll 8
    for (int i = 0; i < 32; ++i) { const int kk = 2 * i + (lane >> 5), cc = lane & 31; scr[kk * 33 + cc] = (cc < nvalid) ? src[(size_t)kk * ld + cc] : 0.f; }
    asm volatile("s_waitcnt lgkmcnt(0)" ::: "memory");
    const int c = lane & 7;
#pragma unroll
    for (int j = 0; j < 4; ++j) { const int n = (lane >> 3) + 8 * j; const LAS float* s = scr + (8 * c) * 33 + n;
        u32x4 o; o.x = cvt_pk_bf16(s[0 * 33], s[1 * 33]); o.y = cvt_pk_bf16(s[2 * 33], s[3 * 33]); o.z = cvt_pk_bf16(s[4 * 33], s[5 * 33]); o.w = cvt_pk_bf16(s[6 * 33], s[7 * 33]);
        *(u32x4*)(dst + (size_t)n * ldd + 8 * c) = o; }
    asm volatile("s_waitcnt lgkmcnt(0)" ::: "memory");
}
template <int MAP> __device__ __forceinline__ void transpose_w(const float* src, int K, int ldsrc, int nsrc, u16* dst, int ndst, LAS float* scr, int gw, int ngw, int lane) {
    const int nkb = K / 64, nitems = (ndst / 32) * nkb;
    for (int it = gw; it < nitems; it += ngw) {
        const int nb = it / nkb, kb = it % nkb, n0 = nb * 32, k0 = kb * 64;
        int c0 = n0;
        if (MAP == 1) { const int j = n0 >> 8, w = n0 & 255; c0 = (w < 128) ? (j * 128 + w) : (FH + j * 128 + (w - 128)); }
        int nvalid = nsrc - c0; nvalid = nvalid > 32 ? 32 : nvalid;
        tr_item(src + (size_t)k0 * ldsrc + c0, ldsrc, nvalid, dst + (size_t)n0 * K + k0, K, scr, lane);
    }
}

__device__ __forceinline__ void phase_prologue(LAS unsigned char* lds, const Params& P) {
    const int tid = opaque_tid(), lane = tid & 63, wid = tid >> 6, bid = blockIdx.x, nb = gridDim.x;
    unsigned char* ws = P.ws;
    {
        LAS float* sl = (LAS float*)lds;
        LAS float* red = sl + 17 * 1024;
        for (int i = tid; i < 17 * 1024; i += 512) { const int mb = i >> 10, k = i & 1023; const float v = mb < 16 ? P.c[mb * 1024 + k] : P.c_ctx[k]; sl[i] = siluf_(v); }
        BLOCK_SYNC();
        float* MOD = (float*)(ws + WS_MOD);
        for (int item = bid; item < 4 * 96; item += nb) {
            const int l = item / 96, n0 = (item % 96) * 64, col = tid & 63, kg = tid >> 6;
            float a[17];
#pragma unroll
            for (int i = 0; i < 17; ++i) a[i] = 0.f;
            const float* w = P.mod_w + ((size_t)l * 1024 + kg * 128) * 6144 + n0 + col;
            for (int kk = 0; kk < 128; ++kk) { const float wv = w[(size_t)kk * 6144];
#pragma unroll
                for (int i = 0; i < 17; ++i) a[i] += sl[i * 1024 + kg * 128 + kk] * wv; }
#pragma unroll
            for (int i = 0; i < 17; ++i) red[(kg * 17 + i) * 64 + col] = a[i];
            BLOCK_SYNC();
            for (int o = tid; o < 17 * 64; o += 512) { const int mb = o >> 6, cc = o & 63; float s = P.mod_b[l * 6144 + n0 + cc];
#pragma unroll
                for (int k8 = 0; k8 < 8; ++k8) s += red[(k8 * 17 + mb) * 64 + cc];
                MOD[((size_t)l * 17 + mb) * 6144 + n0 + cc] = s; }
            BLOCK_SYNC();
        }
    }
    BLOCK_SYNC();
    for (int i = bid * 512 + tid; i < 2048; i += nb * 512) ((float*)(ws + WS_SP8))[i] = 8.0f * log1pf(__expf(-P.lru_lambda[i]));
    LAS float* scr = (LAS float*)(lds + wid * 8448);
    const int gw = bid * 8 + wid, ngw = nb * 8;
    for (int l = 0; l < 4; ++l) {
        transpose_w<1>(P.ffn_w_up + (size_t)l * 1024 * F2, 1024, F2, F2, (u16*)(ws + WS_FFN_UP_T + l * SZ_FFN_UP_T), F2, scr, gw, ngw, lane);
        transpose_w<0>(P.ffn_w_down + (size_t)l * FH * 1024, FH, 1024, 1024, (u16*)(ws + WS_FFN_DN_T + l * SZ_FFN_DN_T), 1024, scr, gw, ngw, lane);
    }
    for (int j = 0; j < 2; ++j) {
        transpose_w<0>(P.cm_w_in + (size_t)j * 1024 * 4096, 1024, 4096, 4096, (u16*)(ws + WS_CM_IN_T) + (size_t)j * 4096 * 1024, 4096, scr, gw, ngw, lane);
        transpose_w<0>(P.cm_w_out + (size_t)j * 2048 * 1024, 2048, 1024, 1024, (u16*)(ws + WS_CM_OUT_T) + (size_t)j * 1024 * 2048, 1024, scr, gw, ngw, lane);
    }
    transpose_w<0>(P.lru_w_in, 1024, 2048, 2048, (u16*)(ws + WS_LRU_IN_T), 2048, scr, gw, ngw, lane);
    transpose_w<0>(P.lru_w_out, 1024, 1024, 1024, (u16*)(ws + WS_LRU_OUT_T), 1024, scr, gw, ngw, lane);
    transpose_w<0>(P.ml_w_in, 1024, 3088, 3088, (u16*)(ws + WS_ML_IN_T), 3328, scr, gw, ngw, lane);
    transpose_w<0>(P.ml_w_out, 1024, 1024, 1024, (u16*)(ws + WS_ML_OUT_T), 1024, scr, gw, ngw, lane);
    for (int q = 0; q < 32; ++q) {
        const int h = q >> 3, tn = (q >> 1) & 3, gate = q & 1, d = tn >> 1, jb = tn & 1;
        const float* src = (gate ? P.lru_w_ig : P.lru_w_rg) + (size_t)(d * 4 + h) * 256 * 256 + jb * 128;
        u16* dst = (u16*)(ws + WS_LRU_G_T) + ((size_t)h * 1024 + tn * 256 + gate * 128) * 256;
        transpose_w<0>(src, 256, 256, 128, dst, 128, scr, (gw + q * 16) % ngw, ngw, lane);
    }
}

__device__ __forceinline__ void phase_prenorm(const float* xl, const float* xc, const float* g, const float* modl, int shoff, int scoff, u16* H, int nrows) {
    const int tid_ = opaque_tid(); const int lane = tid_ & 63, gw = blockIdx.x * 8 + (tid_ >> 6), ngw = gridDim.x * 8;
    for (int r = gw; r < nrows; r += ngw) {
        const bool lat = r < ML; const float* xr = lat ? xl + (size_t)r * 1024 : xc + (size_t)(r - ML) * 1024; const int mb = lat ? (r >> 12) : 16;
        f32x4 v[4]; float ss = 0.f;
#pragma unroll
        for (int j = 0; j < 4; ++j) { v[j] = ((const f32x4*)xr)[lane + 64 * j]; ss += (v[j].x * v[j].x + v[j].y * v[j].y) + (v[j].z * v[j].z + v[j].w * v[j].w); }
        const float rstd = rsqrtf(wave_sum(ss) * (1.0f / 1024.0f) + 1e-6f);
        const float* mp = modl + (size_t)mb * 6144;
#pragma unroll
        for (int j = 0; j < 4; ++j) { const int c = (lane + 64 * j) * 4;
            const f32x4 gg = *(const f32x4*)(g + c), sc = *(const f32x4*)(mp + scoff + c), sh = *(const f32x4*)(mp + shoff + c);
            const f32x4 y = v[j] * rstd * gg; const f32x4 hh = y * (sc + 1.0f) + sh;
            u32x2 o; o.x = cvt_pk_bf16(hh.x, hh.y); o.y = cvt_pk_bf16(hh.z, hh.w);
            *(u32x2*)(H + (size_t)r * 1024 + c) = o; }
    }
}
__device__ __forceinline__ void phase_final_norm(float* x, const float* g) {
    const int tid_ = opaque_tid(); const int lane = tid_ & 63, gw = blockIdx.x * 8 + (tid_ >> 6), ngw = gridDim.x * 8;
    for (int r = gw; r < ML; r += ngw) {
        float* xr = x + (size_t)r * 1024; f32x4 v[4]; float ss = 0.f;
#pragma unroll
        for (int j = 0; j < 4; ++j) { v[j] = ((const f32x4*)xr)[lane + 64 * j]; ss += (v[j].x * v[j].x + v[j].y * v[j].y) + (v[j].z * v[j].z + v[j].w * v[j].w); }
        const float rstd = rsqrtf(wave_sum(ss) * (1.0f / 1024.0f) + 1e-6f);
#pragma unroll
        for (int j = 0; j < 4; ++j) { const int c = (lane + 64 * j) * 4; const f32x4 gg = *(const f32x4*)(g + c); ((f32x4*)xr)[lane + 64 * j] = v[j] * rstd * gg; }
    }
}

__device__ __forceinline__ void phase_cm_spatial(LAS unsigned char* lds, u16* U, const u16* V, const float* pstats, const float* w_s, const float* b_s, const float* v_g, const float* v_b, int nchunks) {
    constexpr int LW = 136;
    LAS u16* VT = (LAS u16*)lds;
    LAS u16* WP = (LAS u16*)(lds + 69632);
    LAS float* mu = (LAS float*)(lds + 104448); LAS float* rs = mu + 128; LAS float* t1 = rs + 128; LAS float* t2 = t1 + 128;
    const int tid = opaque_tid(), lane = tid & 63, w = tid >> 6, fr = lane & 15, fq = lane >> 4;
    for (int item = blockIdx.x; item < nchunks * 8; item += gridDim.x) {
        const int ck = item >> 3, g = item & 7, r0 = ck * 128;
        if (tid < 128) { const float* ps = pstats + (size_t)(r0 + tid) * 64; float s = 0.f, ss = 0.f;
            for (int i = 0; i < 32; ++i) { s += ps[2 * i]; ss += ps[2 * i + 1]; }
            const float mean = s * (1.0f / 2048.0f); const float var = fmaxf(ss * (1.0f / 2048.0f) - mean * mean, 0.f);
            mu[tid] = mean; rs[tid] = rsqrtf(var + 1e-6f); }
        BLOCK_SYNC();
#pragma unroll
        for (int j = 0; j < 8; ++j) { const int pc = tid + 512 * j, q = pc & 127, c8 = pc >> 7;
            const u32x4 raw = *(const u32x4*)(V + (size_t)(r0 + q) * 2048 + g * 256 + c8 * 8);
            LAS u16* d = VT + (c8 * 8) * LW + q;
            d[0 * LW] = (u16)(raw.x & 0xffffu); d[1 * LW] = (u16)(raw.x >> 16); d[2 * LW] = (u16)(raw.y & 0xffffu); d[3 * LW] = (u16)(raw.y >> 16);
            d[4 * LW] = (u16)(raw.z & 0xffffu); d[5 * LW] = (u16)(raw.z >> 16); d[6 * LW] = (u16)(raw.w & 0xffffu); d[7 * LW] = (u16)(raw.w >> 16); }
        { const int pr = tid >> 2, part = tid & 3; const float* wrow = w_s + ((size_t)g * 128 + pr) * 128 + part * 32; float a1 = 0.f, a2 = 0.f;
#pragma unroll 8
            for (int qq = 0; qq < 32; ++qq) { const int q = part * 32 + qq; const float wv = wrow[qq]; const u16 wp = f2bf(wv * rs[q]); WP[pr * LW + q] = wp; a1 += bf2f(wp) * mu[q]; a2 += wv; }
            a1 += __shfl_xor(a1, 1); a1 += __shfl_xor(a1, 2); a2 += __shfl_xor(a2, 1); a2 += __shfl_xor(a2, 2);
            if (part == 0) { t1[pr] = a1; t2[pr] = a2; } }
        BLOCK_SYNC();
        f32x4 acc[8][2];
#pragma unroll
        for (int m = 0; m < 8; ++m) { acc[m][0] = (f32x4){0.f, 0.f, 0.f, 0.f}; acc[m][1] = (f32x4){0.f, 0.f, 0.f, 0.f}; }
#pragma unroll
        for (int k = 0; k < 4; ++k) {
            bf16x8 Vf[2];
#pragma unroll
            for (int n = 0; n < 2; ++n) Vf[n] = *(const LAS bf16x8*)(VT + (32 * w + 16 * n + fr) * LW + 32 * k + 8 * fq);
#pragma unroll
            for (int m = 0; m < 8; ++m) { const bf16x8 Wf = *(const LAS bf16x8*)(WP + (16 * m + fr) * LW + 32 * k + 8 * fq);
#pragma unroll
                for (int n = 0; n < 2; ++n) acc[m][n] = __builtin_amdgcn_mfma_f32_16x16x32_bf16(Vf[n], Wf, acc[m][n], 0, 0, 0); }
        }
#pragma unroll
        for (int m = 0; m < 8; ++m) { const int pp = 16 * m + fr; const float tt1 = t1[pp], tt2 = t2[pp], bsp = b_s[g * 128 + pp];
#pragma unroll
            for (int n = 0; n < 2; ++n) { const int cg_ = g * 256 + 32 * w + 16 * n + 4 * fq;
                const f32x4 vg4 = *(const f32x4*)(v_g + cg_), vb4 = *(const f32x4*)(v_b + cg_);
                u16* up = U + (size_t)(r0 + pp) * 2048 + cg_; const u32x2 ur = *(const u32x2*)up;
                const float u0 = bf_lo(ur.x), u1 = bf_hi(ur.x), u2 = bf_lo(ur.y), u3 = bf_hi(ur.y);
                const float s0 = vg4.x * (acc[m][n][0] - tt1) + vb4.x * tt2 + bsp, s1 = vg4.y * (acc[m][n][1] - tt1) + vb4.y * tt2 + bsp;
                const float s2 = vg4.z * (acc[m][n][2] - tt1) + vb4.z * tt2 + bsp, s3 = vg4.w * (acc[m][n][3] - tt1) + vb4.w * tt2 + bsp;
                u32x2 o; o.x = cvt_pk_bf16(u0 * s0, u1 * s1); o.y = cvt_pk_bf16(u2 * s2, u3 * s3); *(u32x2*)up = o; } }
        BLOCK_SYNC();
    }
}

__device__ __forceinline__ void phase_ffn_conv(LAS unsigned char* lds, const u16* Z, int ntile, int j0, const float* cw, const float* cb, u16* A2, bool with_ctx) {
    LAS u16* T = (LAS u16*)lds;
    LAS float* Wc = (LAS float*)(lds + 100352);
    LAS float* Bc = Wc + 9 * 64;
    const int tid = opaque_tid();
    const int n_lat = 16 * 8 * ntile * 4, n_ctx = with_ctx ? 16 * ntile * 4 : 0;
    const int ld = ntile * 256;
    for (int it = blockIdx.x; it < n_lat + n_ctx; it += gridDim.x) {
        const bool isctx = it >= n_lat; const int iu = isctx ? it - n_lat : it;
        const int cq = iu & 3, tj = (iu >> 2) % ntile, rest = (iu >> 2) / ntile;
        int base_row, Hh, wsh, band0, BR;
        if (!isctx) { const int band = rest & 7, b = rest >> 3; base_row = b * 4096; Hh = 64; wsh = 6; band0 = band * 8; BR = 8; }
        else { base_row = ML + rest * 256; Hh = 1; wsh = 8; band0 = 0; BR = 1; }
        const int Wd = 1 << wsh, TW = Wd + 2;
        const int zg = tj * 256 + cq * 32, c0 = (j0 + tj) * 128 + cq * 32;
        const int npieces = (BR + 2) * TW * 8;
        for (int pc = tid; pc < npieces; pc += 512) { const int o = pc & 7, lc = (pc >> 3) % TW, lr = (pc >> 3) / TW; const int gr = band0 + lr - 1, gc = lc - 1;
            u32x4 v = (u32x4){0u, 0u, 0u, 0u};
            if (gr >= 0 && gr < Hh && gc >= 0 && gc < Wd) v = *(const u32x4*)(Z + (size_t)(base_row + gr * Wd + gc) * ld + zg + (o < 4 ? o * 8 : 128 + (o - 4) * 8));
            *(LAS u32x4*)(T + ((size_t)(lr * TW + lc) * 64 + o * 8)) = v; }
        for (int i = tid; i < 9 * 64; i += 512) { const int tap = i >> 6, ch = i & 63; Wc[i] = cw[(size_t)tap * F2 + (ch < 32 ? c0 + ch : FH + c0 + ch - 32)]; }
        if (tid < 64) Bc[tid] = cb[tid < 32 ? c0 + tid : FH + c0 + tid - 32];
        BLOCK_SYNC();
        const int oct = tid & 3, tk = tid >> 2, nitr = (BR * Wd) >> 7;
        float ag[4][8], au[4][8];
#pragma unroll
        for (int itr = 0; itr < 4; ++itr)
#pragma unroll
            for (int e = 0; e < 8; ++e) { ag[itr][e] = Bc[oct * 8 + e]; au[itr][e] = Bc[32 + oct * 8 + e]; }
#pragma unroll
        for (int tap = 0; tap < 9; ++tap) { const int di = tap / 3, dj = tap % 3;
            if (isctx && di != 1) continue;
            float wg[8], wu[8];
#pragma unroll
            for (int e = 0; e < 8; ++e) { wg[e] = Wc[tap * 64 + oct * 8 + e]; wu[e] = Wc[tap * 64 + 32 + oct * 8 + e]; }
#pragma unroll
            for (int itr = 0; itr < 4; ++itr) { if (itr < nitr) { const int token = itr * 128 + tk, lrow = token >> wsh, col = token & (Wd - 1);
                const LAS u16* tp = T + ((size_t)((lrow + di) * TW + col + dj) * 64 + oct * 8);
                float zgv[8], zuv[8]; unpack8(*(const LAS u32x4*)tp, zgv); unpack8(*(const LAS u32x4*)(tp + 32), zuv);
#pragma unroll
                for (int e = 0; e < 8; ++e) { ag[itr][e] += wg[e] * zgv[e]; au[itr][e] += wu[e] * zuv[e]; } } }
        }
#pragma unroll
        for (int itr = 0; itr < 4; ++itr) { if (itr < nitr) { const int token = itr * 128 + tk, lrow = token >> wsh, col = token & (Wd - 1);
            const size_t r = (size_t)base_row + (size_t)(band0 + lrow) * Wd + col; float o8[8];
#pragma unroll
            for (int e = 0; e < 8; ++e) o8[e] = siluf_(ag[itr][e]) * au[itr][e];
            *(u32x4*)(A2 + r * FH + c0 + oct * 8) = pack8(o8); } }
        BLOCK_SYNC();
    }
}

__device__ __forceinline__ void phase_lru_conv(const u16* XR, const float* cw  , const float* cb, u16* XCV) {
    const size_t total = (size_t)MT * 128, stride = (size_t)gridDim.x * 512;
    const int tid_ = opaque_tid();
    for (size_t idx = (size_t)blockIdx.x * 512 + tid_; idx < total; idx += stride) {
        const int r = (int)(idx >> 7), oct = (int)(idx & 127), c = oct * 8;
        int t, len; if (r < ML) { t = r & 4095; len = 4096; } else { t = (r - ML) & 255; len = 256; }
        float a[8];
#pragma unroll
        for (int e = 0; e < 8; ++e) a[e] = cb[c + e];
#pragma unroll
        for (int k = 0; k < 4; ++k) { const int tt = t + k - 2; if (tt >= 0 && tt < len) { float xv[8]; unpack8(*(const u32x4*)(XR + (size_t)(r + k - 2) * 1024 + c), xv);
#pragma unroll
            for (int e = 0; e < 8; ++e) a[e] += cw[k * 1024 + c + e] * xv[e]; } }
        *(u32x4*)(XCV + (size_t)r * 1024 + c) = pack8(a);
    }
}

__device__ __forceinline__ void phase_lru_scanA(const u16* LA0, const u16* B0, const u16* LA1, const u16* B1, float* SEG) {
    const int tid = opaque_tid();
    for (int it = blockIdx.x; it < 272 * 2 * 2; it += gridDim.x) {
        const int cb = it & 1, dir = (it >> 1) & 1, sid = it >> 2, ch = cb * 512 + tid;
        const u16* la = (dir ? LA1 : LA0) + (size_t)sid * 256 * 1024 + ch; const u16* bb = (dir ? B1 : B0) + (size_t)sid * 256 * 1024 + ch;
        float ps = 0.f, e = 0.f;
#pragma unroll 8
        for (int i = 0; i < 256; ++i) { const int t = dir ? 255 - i : i; const float lg = bf2f(la[(size_t)t * 1024]), bv = bf2f(bb[(size_t)t * 1024]); ps += lg; e = __expf(lg) * e + bv; }
        *(f32x2*)(SEG + (((size_t)dir * 272 + sid) * 1024 + ch) * 2) = (f32x2){ps, e};
    }
}
__device__ __forceinline__ void phase_lru_scanB(const float* SEG, float* CARRY) {
    const int gt = blockIdx.x * 512 + opaque_tid();
    if (gt < 16 * 2 * 1024) { const int ch = gt & 1023, dir = (gt >> 10) & 1, b = gt >> 11;
        float st = 0.f;
        { const int sid = 256 + b; const size_t o = ((size_t)dir * 272 + sid) * 1024 + ch; CARRY[o] = 0.f; const f32x2 pe = *(const f32x2*)(SEG + o * 2); st = pe.y; }
        for (int i = 0; i < 16; ++i) { const int s = dir ? 15 - i : i, sid = b * 16 + s; const size_t o = ((size_t)dir * 272 + sid) * 1024 + ch;
            CARRY[o] = st; const f32x2 pe = *(const f32x2*)(SEG + o * 2); st = __expf(pe.x) * st + pe.y; }
    }
}
__device__ __forceinline__ void phase_lru_scanC(const u16* LA0, u16* B0, const u16* LA1, const u16* B1, const float* CARRY, const u16* Y, u16* G) {
    const int tid = opaque_tid();
    for (int it = blockIdx.x; it < 272 * 2; it += gridDim.x) {
        const int cb = it & 1, sid = it >> 1, ch = cb * 512 + tid; const size_t base = (size_t)sid * 256 * 1024 + ch;
        float h = CARRY[((size_t)0 * 272 + sid) * 1024 + ch];
#pragma unroll 8
        for (int t = 0; t < 256; ++t) { const size_t o = base + (size_t)t * 1024; h = __expf(bf2f(LA0[o])) * h + bf2f(B0[o]); B0[o] = f2bf(h); }
        h = CARRY[((size_t)1 * 272 + sid) * 1024 + ch];
#pragma unroll 8
        for (int i = 0; i < 256; ++i) { const int t = 255 - i; const size_t o = base + (size_t)t * 1024; h = __expf(bf2f(LA1[o])) * h + bf2f(B1[o]);
            G[o] = f2bf((bf2f(B0[o]) + h) * bf2f(Y[o])); }
    }
}

__device__ __forceinline__ void phase_mlstm(LAS unsigned char* lds, const u16* Q, const u16* Kx, const u16* V, const float* gates, u16* HF, u16* HB) {
    constexpr int LW = 136;
    LAS u16* R1 = (LAS u16*)lds;
    LAS u16* R2 = R1 + 128 * LW;
    LAS u16* VTs = R2 + 128 * LW;
    LAS u16* CTs = VTs + 128 * LW;
    LAS float* fb = (LAS float*)(CTs + 128 * LW);
    LAS float *lfv = fb, *igv = fb + 128, *bcum = fb + 256, *mtv = fb + 384, *iwv = fb + 512, *wv = fb + 640, *nvec = fb + 768, *qn = fb + 896, *den = fb + 1024, *rs2 = fb + 1152;
    const int tid = opaque_tid(), lane = tid & 63, wid = tid >> 6, wr = wid >> 1, wc = wid & 1, fr = lane & 15, fq = lane >> 4;
    for (int item = blockIdx.x; item < 256; item += gridDim.x) {
        const int half = item & 1, dir = (item >> 1) & 1, h = (item >> 2) & 3, b = item >> 4;
        u16* HO = dir ? HB : HF;
        f32x4 accC[2][4];
#pragma unroll
        for (int a = 0; a < 2; ++a)
#pragma unroll
            for (int n = 0; n < 4; ++n) accC[a][n] = (f32x4){0.f, 0.f, 0.f, 0.f};
        for (int i = tid; i < 128 * LW / 2; i += 512) ((LAS unsigned*)CTs)[i] = 0u;
        if (tid < 128) nvec[tid] = 0.f;
        float mstate = 0.f;
        BLOCK_SYNC();
        for (int step = 0; step < 34; ++step) {
            int base;
            if (step < 2) { const int cc = dir ? 1 - step : step; base = ML + b * 256 + cc * 128; }
            else { const int lc = step - 2, cc = dir ? 31 - lc : lc; base = b * 4096 + cc * 128; }
#pragma unroll
            for (int j = 0; j < 4; ++j) { const int pc = tid + 512 * j, i = pc & 127, c8 = pc >> 7; const size_t row = (size_t)base + (dir ? 127 - i : i);
                const u32x4 q16 = *(const u32x4*)(Q + row * 512 + h * 128 + c8 * 8); *(LAS u32x4*)(R1 + i * LW + c8 * 8) = q16;
                const u32x4 k16 = *(const u32x4*)(Kx + row * 512 + h * 128 + c8 * 8); *(LAS u32x4*)(R2 + i * LW + c8 * 8) = k16;
                const u32x4 raw = *(const u32x4*)(V + row * 1024 + h * 256 + half * 128 + c8 * 8);
                LAS u16* d = VTs + (c8 * 8) * LW + i;
                d[0 * LW] = (u16)(raw.x & 0xffffu); d[1 * LW] = (u16)(raw.x >> 16); d[2 * LW] = (u16)(raw.y & 0xffffu); d[3 * LW] = (u16)(raw.y >> 16);
                d[4 * LW] = (u16)(raw.z & 0xffffu); d[5 * LW] = (u16)(raw.z >> 16); d[6 * LW] = (u16)(raw.w & 0xffffu); d[7 * LW] = (u16)(raw.w >> 16); }
            if (tid < 128) { const size_t row = (size_t)base + (dir ? 127 - tid : tid); igv[tid] = gates[row * 16 + dir * 8 + h];
                const float f = gates[row * 16 + dir * 8 + 4 + h]; lfv[tid] = fminf(f, 0.f) - log1pf(__expf(-fabsf(f))); }
            BLOCK_SYNC();
            if (tid < 128) { float bs = 0.f, pm = -INFINITY;
                for (int s = 0; s <= tid; ++s) { bs += lfv[s]; pm = fmaxf(pm, igv[s] - bs); }
                const float mt_ = bs + fmaxf(mstate, pm); bcum[tid] = bs; mtv[tid] = mt_; iwv[tid] = __expf(bs + mstate - mt_);
                float dq = 0.f;
#pragma unroll 2
                for (int c8 = 0; c8 < 16; ++c8) { float qv[8]; unpack8(*(const LAS u32x4*)(R1 + tid * LW + c8 * 8), qv);
#pragma unroll
                    for (int e = 0; e < 8; ++e) dq += qv[e] * nvec[c8 * 8 + e]; }
                qn[tid] = dq; }
            BLOCK_SYNC();
            const float m_new = mtv[127], b_end = bcum[127], decay = __expf(b_end + mstate - m_new);
            if (tid < 128) wv[tid] = __expf(b_end - bcum[tid] + igv[tid] - m_new);
            f32x4 accS[2][4], accH[2][4];
#pragma unroll
            for (int a = 0; a < 2; ++a)
#pragma unroll
                for (int n = 0; n < 4; ++n) { accS[a][n] = (f32x4){0.f, 0.f, 0.f, 0.f}; accH[a][n] = (f32x4){0.f, 0.f, 0.f, 0.f}; }
#pragma unroll 1
            for (int k = 0; k < 4; ++k) {
                bf16x8 Qf[2];
#pragma unroll
                for (int a = 0; a < 2; ++a) Qf[a] = *(const LAS bf16x8*)(R1 + (32 * wr + 16 * a + fr) * LW + 32 * k + 8 * fq);
#pragma unroll
                for (int n = 0; n < 4; ++n) { const bf16x8 Kf = *(const LAS bf16x8*)(R2 + (64 * wc + 16 * n + fr) * LW + 32 * k + 8 * fq);
#pragma unroll
                    for (int a = 0; a < 2; ++a) accS[a][n] = __builtin_amdgcn_mfma_f32_16x16x32_bf16(Kf, Qf[a], accS[a][n], 0, 0, 0); }
#pragma unroll
                for (int n = 0; n < 4; ++n) { const bf16x8 Cf = *(const LAS bf16x8*)(CTs + (64 * wc + 16 * n + fr) * LW + 32 * k + 8 * fq);
#pragma unroll
                    for (int a = 0; a < 2; ++a) accH[a][n] = __builtin_amdgcn_mfma_f32_16x16x32_bf16(Cf, Qf[a], accH[a][n], 0, 0, 0); }
            }
            BLOCK_SYNC();
#pragma unroll
            for (int a = 0; a < 2; ++a) { const int t = 32 * wr + 16 * a + fr; const float bt = bcum[t], mtt = mtv[t]; float rsum = 0.f;
#pragma unroll
                for (int n = 0; n < 4; ++n) { const int s0 = 64 * wc + 16 * n + 4 * fq; float sv[4];
#pragma unroll
                    for (int j = 0; j < 4; ++j) { const int s = s0 + j; const float dwv = (s <= t) ? __expf(bt - bcum[s] + igv[s] - mtt) : 0.f; sv[j] = accS[a][n][j] * dwv; rsum += sv[j]; }
                    u32x2 o; o.x = cvt_pk_bf16(sv[0], sv[1]); o.y = cvt_pk_bf16(sv[2], sv[3]); *(LAS u32x2*)(R2 + t * LW + s0) = o; }
                rsum += __shfl_xor(rsum, 16); rsum += __shfl_xor(rsum, 32); if (fq == 0) rs2[t * 2 + wc] = rsum; }
#pragma unroll
            for (int j = 0; j < 4; ++j) { const int pc = tid + 512 * j, i = pc & 127, c8 = pc >> 7; const float wgt = wv[i]; const size_t row = (size_t)base + (dir ? 127 - i : i); float kv[8]; unpack8(*(const u32x4*)(Kx + row * 512 + h * 128 + c8 * 8), kv);
                LAS u16* d = R1 + (c8 * 8) * LW + i;
#pragma unroll
                for (int e = 0; e < 8; ++e) d[e * LW] = f2bf(kv[e] * wgt); }
            BLOCK_SYNC();
            if (tid < 128) { float sn = 0.f;
#pragma unroll 2
                for (int c8 = 0; c8 < 16; ++c8) { float kv[8]; unpack8(*(const LAS u32x4*)(R1 + tid * LW + c8 * 8), kv);
#pragma unroll
                    for (int e = 0; e < 8; ++e) sn += kv[e]; }
                nvec[tid] = decay * nvec[tid] + sn;
            } else if (tid < 256) { const int t = tid - 128; den[t] = iwv[t] * qn[t] + rs2[2 * t] + rs2[2 * t + 1]; }
#pragma unroll
            for (int a = 0; a < 2; ++a) { const float iw = iwv[32 * wr + 16 * a + fr];
#pragma unroll
                for (int n = 0; n < 4; ++n) { accH[a][n] = accH[a][n] * iw; accC[a][n] = accC[a][n] * decay; } }
#pragma unroll 1
            for (int k = 0; k < 4; ++k) {
                bf16x8 Sf[2], VTf[2];
#pragma unroll
                for (int a = 0; a < 2; ++a) { Sf[a] = *(const LAS bf16x8*)(R2 + (32 * wr + 16 * a + fr) * LW + 32 * k + 8 * fq); VTf[a] = *(const LAS bf16x8*)(VTs + (32 * wr + 16 * a + fr) * LW + 32 * k + 8 * fq); }
#pragma unroll
                for (int n = 0; n < 4; ++n) { const bf16x8 Vf = *(const LAS bf16x8*)(VTs + (64 * wc + 16 * n + fr) * LW + 32 * k + 8 * fq);
                    const bf16x8 KTf = *(const LAS bf16x8*)(R1 + (64 * wc + 16 * n + fr) * LW + 32 * k + 8 * fq);
#pragma unroll
                    for (int a = 0; a < 2; ++a) { accH[a][n] = __builtin_amdgcn_mfma_f32_16x16x32_bf16(Vf, Sf[a], accH[a][n], 0, 0, 0);
                        accC[a][n] = __builtin_amdgcn_mfma_f32_16x16x32_bf16(KTf, VTf[a], accC[a][n], 0, 0, 0); } }
            }
            BLOCK_SYNC();
#pragma unroll
            for (int a = 0; a < 2; ++a) { const int t = 32 * wr + 16 * a + fr; const float dn = fmaxf(fabsf(den[t]), __expf(-mtv[t])); const float inv = 1.0f / dn;
                const size_t row = (size_t)base + (dir ? 127 - t : t);
#pragma unroll
                for (int n = 0; n < 4; ++n) { const int e0 = 64 * wc + 16 * n + 4 * fq;
                    u32x2 o; o.x = cvt_pk_bf16(accH[a][n][0] * inv, accH[a][n][1] * inv); o.y = cvt_pk_bf16(accH[a][n][2] * inv, accH[a][n][3] * inv);
                    *(u32x2*)(HO + row * 1024 + h * 256 + half * 128 + e0) = o;
                    u32x2 cpk; cpk.x = cvt_pk_bf16(accC[a][n][0], accC[a][n][1]); cpk.y = cvt_pk_bf16(accC[a][n][2], accC[a][n][3]);
                    *(LAS u32x2*)(CTs + (32 * wr + 16 * a + fr) * LW + e0) = cpk; } }
            mstate = m_new;
            BLOCK_SYNC();
        }
    }
}
__device__ __forceinline__ void phase_ml_readout(const u16* HF, const u16* HB, const u16* O, const float* ng, u16* G) {
    const int tid_ = opaque_tid(); const int lane = tid_ & 63, gw = blockIdx.x * 8 + (tid_ >> 6), ngw = gridDim.x * 8;
    for (int r = gw; r < MT; r += ngw) { const size_t off = (size_t)r * 1024 + lane * 16;
        float hs[16], a[8], bq[8];
        unpack8(*(const u32x4*)(HF + off), a); unpack8(*(const u32x4*)(HB + off), bq);
#pragma unroll
        for (int e = 0; e < 8; ++e) hs[e] = a[e] + bq[e];
        unpack8(*(const u32x4*)(HF + off + 8), a); unpack8(*(const u32x4*)(HB + off + 8), bq);
#pragma unroll
        for (int e = 0; e < 8; ++e) hs[8 + e] = a[e] + bq[e];
        float ss = 0.f;
#pragma unroll
        for (int e = 0; e < 16; ++e) ss += hs[e] * hs[e];
        ss += __shfl_xor(ss, 1); ss += __shfl_xor(ss, 2); ss += __shfl_xor(ss, 4); ss += __shfl_xor(ss, 8);
        const float rstd = rsqrtf(ss * (1.0f / 256.0f) + 1e-6f);
        float o0[8], o1[8], g0[8], g1[8];
        unpack8(*(const u32x4*)(O + off), o0); unpack8(*(const u32x4*)(O + off + 8), o1);
#pragma unroll
        for (int e = 0; e < 8; ++e) { g0[e] = o0[e] * hs[e] * rstd * ng[lane * 16 + e]; g1[e] = o1[e] * hs[8 + e] * rstd * ng[lane * 16 + 8 + e]; }
        *(u32x4*)(G + off) = pack8(g0); *(u32x4*)(G + off + 8) = pack8(g1);
    }
}

constexpr int PTAB_OFF = LDS_BYTES - 512;
enum { I_X = 0, I_C, I_CTX, I_CCTX, I_N1G, I_N2G, I_MODW, I_MODB, I_FUP, I_FCW, I_FCB, I_FDN, I_CMIN, I_CMBIN, I_CMVG, I_CMVB, I_CMWS, I_CMBS, I_CMOUT,
       I_LIN, I_LCW, I_LCB, I_LWRG, I_LBRG, I_LWIG, I_LBIG, I_LLAM, I_LOUT, I_MIN, I_MBG, I_MNG, I_MOUT, I_FNG, I_OUT, I_WS };
__device__ __forceinline__ unsigned char* getp(LAS unsigned char* lds, int idx) {
    unsigned a = PTAB_OFF; asm volatile("" : "+v"(a));
    volatile LAS unsigned* t = (volatile LAS unsigned*)(lds + a);
    unsigned lo = t[2 * idx], hi = t[2 * idx + 1];
    lo = __builtin_amdgcn_readfirstlane(lo); hi = __builtin_amdgcn_readfirstlane(hi);
    return (unsigned char*)(((unsigned long long)hi << 32) | (unsigned long long)lo);
}
#define GF(i) ((const float*)getp(lds, (i)))
#define WSP(off) (getp(lds, I_WS) + (off))

__global__ void __launch_bounds__(512, 2) mega_fwd(Params P) {
    extern __shared__ __attribute__((aligned(16))) unsigned char shm[];
    LAS unsigned char* lds = (LAS unsigned char*)shm;
    cg::grid_group grid = cg::this_grid();
    if (threadIdx.x < 35) { const unsigned long long v = ((const unsigned long long*)&P)[threadIdx.x]; LAS unsigned* t = (LAS unsigned*)(lds + PTAB_OFF); t[2 * threadIdx.x] = (unsigned)v; t[2 * threadIdx.x + 1] = (unsigned)(v >> 32); }
    BLOCK_SYNC();
    phase_prologue(lds, P);
    grid.sync();

#pragma unroll 1
    for (int l = 0; l < 4; ++l) {
        const int kind = l % 3, j = l / 3; const bool last = (l == 3);
        const int nM = last ? 256 : 272, nrows = last ? ML : MT;
        {
            const float* xsl = (l == 0) ? GF(I_X) : GF(I_OUT); const float* xsc = (l == 0) ? GF(I_CTX) : (const float*)WSP(WS_XC);
            phase_prenorm(xsl, xsc, GF(I_N1G) + l * 1024, (const float*)WSP(WS_MOD) + (size_t)l * 17 * 6144, 0, 1024, (u16*)WSP(WS_ACT), nrows);
        }
        grid.sync();
        g8::Desc dout{};
        if (kind == 0) {
            { g8::Desc d{}; d.A = (const u16*)WSP(WS_ACT); d.Bt = (const u16*)WSP(WS_CM_IN_T) + (size_t)j * 4096 * 1024; d.lda = 1024; d.ldb = 1024; d.K = 1024; d.nM = nM; d.nN = 16; d.nZ = 1;
              Epi<M_CMIN> E{}; E.p.o0 = (u16*)WSP(WS_ACT + SLOT); E.p.o1 = (u16*)WSP(WS_ACT + 3 * SLOT); E.p.f0 = (float*)WSP(WS_ACT + 6 * SLOT); E.p.bias = GF(I_CMBIN) + j * 4096;
              g8::gemm_phase(lds, d, E); }
            grid.sync();
            phase_cm_spatial(lds, (u16*)WSP(WS_ACT + SLOT), (const u16*)WSP(WS_ACT + 3 * SLOT), (const float*)WSP(WS_ACT + 6 * SLOT), GF(I_CMWS) + (size_t)j * 8 * 128 * 128, GF(I_CMBS) + j * 8 * 128,
                             GF(I_CMVG) + j * 2048, GF(I_CMVB) + j * 2048, nrows / 128);
            grid.sync();
            dout.A = (const u16*)WSP(WS_ACT + SLOT); dout.Bt = (const u16*)WSP(WS_CM_OUT_T) + (size_t)j * 1024 * 2048; dout.lda = 2048; dout.ldb = 2048; dout.K = 2048;
        } else if (kind == 1) {
            { g8::Desc d{}; d.A = (const u16*)WSP(WS_ACT); d.Bt = (const u16*)WSP(WS_LRU_IN_T); d.lda = 1024; d.ldb = 1024; d.K = 1024; d.nM = nM; d.nN = 8; d.nZ = 1;
              Epi<M_LRUIN> E{}; E.p.o0 = (u16*)WSP(WS_ACT + SLOT); E.p.o1 = (u16*)WSP(WS_ACT + 2 * SLOT);
              g8::gemm_phase(lds, d, E); }
            grid.sync();
            phase_lru_conv((const u16*)WSP(WS_ACT + 2 * SLOT), GF(I_LCW), GF(I_LCB), (u16*)WSP(WS_ACT + 3 * SLOT));
            grid.sync();
            { g8::Desc d{}; d.A = (const u16*)WSP(WS_ACT + 3 * SLOT); d.Bt = (const u16*)WSP(WS_LRU_G_T); d.lda = 1024; d.ldb = 256; d.K = 256; d.nM = nM; d.nN = 4; d.nZ = 4; d.zA = 256; d.zB = (size_t)1024 * 256;
              Epi<M_LRUG> E{}; E.p.o0 = (u16*)WSP(WS_ACT); E.p.o1 = (u16*)WSP(WS_ACT + 2 * SLOT); E.p.o2 = (u16*)WSP(WS_ACT + 4 * SLOT); E.p.o3 = (u16*)WSP(WS_ACT + 5 * SLOT);
              E.p.q0 = GF(I_LBRG); E.p.q1 = GF(I_LBIG); E.p.q2 = (const float*)WSP(WS_SP8); E.p.bsrc = (const u16*)WSP(WS_ACT + 3 * SLOT);
              g8::gemm_phase(lds, d, E); }
            grid.sync();
            phase_lru_scanA((const u16*)WSP(WS_ACT), (const u16*)WSP(WS_ACT + 2 * SLOT), (const u16*)WSP(WS_ACT + 4 * SLOT), (const u16*)WSP(WS_ACT + 5 * SLOT), (float*)WSP(WS_SEG));
            grid.sync();
            phase_lru_scanB((const float*)WSP(WS_SEG), (float*)WSP(WS_CARRY));
            grid.sync();
            phase_lru_scanC((const u16*)WSP(WS_ACT), (u16*)WSP(WS_ACT + 2 * SLOT), (const u16*)WSP(WS_ACT + 4 * SLOT), (const u16*)WSP(WS_ACT + 5 * SLOT), (const float*)WSP(WS_CARRY),
                            (const u16*)WSP(WS_ACT + SLOT), (u16*)WSP(WS_ACT + 3 * SLOT));
            grid.sync();
            dout.A = (const u16*)WSP(WS_ACT + 3 * SLOT); dout.Bt = (const u16*)WSP(WS_LRU_OUT_T); dout.lda = 1024; dout.ldb = 1024; dout.K = 1024;
        } else {
            { g8::Desc d{}; d.A = (const u16*)WSP(WS_ACT); d.Bt = (const u16*)WSP(WS_ML_IN_T); d.lda = 1024; d.ldb = 1024; d.K = 1024; d.nM = nM; d.nN = 13; d.nZ = 1;
              Epi<M_MLIN> E{}; E.p.o0 = (u16*)WSP(WS_ACT + SLOT); E.p.o1 = (u16*)WSP(WS_ACT + SLOT) + (size_t)MT * 512; E.p.o2 = (u16*)WSP(WS_ACT + 2 * SLOT); E.p.o3 = (u16*)WSP(WS_ACT + 3 * SLOT);
              E.p.f0 = (float*)WSP(WS_ACT + 6 * SLOT); E.p.bias = GF(I_MBG);
              g8::gemm_phase(lds, d, E); }
            grid.sync();
            phase_mlstm(lds, (const u16*)WSP(WS_ACT + SLOT), (const u16*)WSP(WS_ACT + SLOT) + (size_t)MT * 512, (const u16*)WSP(WS_ACT + 2 * SLOT), (const float*)WSP(WS_ACT + 6 * SLOT),
                        (u16*)WSP(WS_ACT + 4 * SLOT), (u16*)WSP(WS_ACT + 5 * SLOT));
            grid.sync();
            phase_ml_readout((const u16*)WSP(WS_ACT + 4 * SLOT), (const u16*)WSP(WS_ACT + 5 * SLOT), (const u16*)WSP(WS_ACT + 3 * SLOT), GF(I_MNG), (u16*)WSP(WS_ACT));
            grid.sync();
            dout.A = (const u16*)WSP(WS_ACT); dout.Bt = (const u16*)WSP(WS_ML_OUT_T); dout.lda = 1024; dout.ldb = 1024; dout.K = 1024;
        }
        { dout.nM = nM; dout.nN = 4; dout.nZ = 1;
          Epi<M_RES> E{}; E.p.xsl = (l == 0) ? GF(I_X) : GF(I_OUT); E.p.xsc = (l == 0) ? GF(I_CTX) : (const float*)WSP(WS_XC); E.p.xdl = (float*)getp(lds, I_OUT); E.p.xdc = (float*)WSP(WS_XC);
          E.p.gate = (const float*)WSP(WS_MOD) + (size_t)l * 17 * 6144 + 2048;
          g8::gemm_phase(lds, dout, E); }
        grid.sync();
        phase_prenorm(GF(I_OUT), (const float*)WSP(WS_XC), GF(I_N2G) + l * 1024, (const float*)WSP(WS_MOD) + (size_t)l * 17 * 6144, 3072, 4096, (u16*)WSP(WS_ACT), nrows);
        grid.sync();
#pragma unroll 1
        for (int part = 0; part < 2; ++part) {
            const int pn0 = part ? 11 : 0, nt = part ? 10 : 11;
            { g8::Desc d{}; d.A = (const u16*)WSP(WS_ACT); d.Bt = (const u16*)WSP(WS_FFN_UP_T + l * SZ_FFN_UP_T); d.lda = 1024; d.ldb = 1024; d.K = 1024; d.nM = nM; d.nN = nt; d.nZ = 1; d.pn0 = pn0;
              Epi<M_BF16> E{}; E.p.o0 = (u16*)WSP(WS_ACT + SLOT); E.p.ldc = nt * 256; E.p.pn0 = pn0;
              g8::gemm_phase(lds, d, E); }
            grid.sync();
            phase_ffn_conv(lds, (const u16*)WSP(WS_ACT + SLOT), nt, pn0, GF(I_FCW) + (size_t)l * 9 * F2, GF(I_FCB) + (size_t)l * F2, (u16*)WSP(WS_ACT + SLOT + (size_t)MT * 2816 * 2), !last);
            grid.sync();
        }
        { g8::Desc d{}; d.A = (const u16*)WSP(WS_ACT + SLOT + (size_t)MT * 2816 * 2); d.Bt = (const u16*)WSP(WS_FFN_DN_T + l * SZ_FFN_DN_T); d.lda = FH; d.ldb = FH; d.K = FH; d.nM = nM; d.nN = 4; d.nZ = 1;
          Epi<M_RES> E{}; E.p.xsl = GF(I_OUT); E.p.xsc = (const float*)WSP(WS_XC); E.p.xdl = (float*)getp(lds, I_OUT); E.p.xdc = (float*)WSP(WS_XC);
          E.p.gate = (const float*)WSP(WS_MOD) + (size_t)l * 17 * 6144 + 5120;
          g8::gemm_phase(lds, d, E); }
        grid.sync();
    }
    phase_final_norm((float*)getp(lds, I_OUT), GF(I_FNG));
}

extern "C" void kernel_launch(void* const* d_in, const int* in_sizes, int n_in, void* d_out, int out_size, void* d_ws, size_t ws_size, hipStream_t stream) {
    static int grid = 0;
    if (grid == 0) {
        if (n_in != 33 || ws_size < WS_END) { fprintf(stderr, "kernel_launch: unexpected n_in %d or ws_size %zu (< %zu)\n", n_in, ws_size, (size_t)WS_END); grid = -1; return; }
        int dev = 0, cus = 0, per_cu = 0;
        hipGetDevice(&dev); hipDeviceGetAttribute(&cus, hipDeviceAttributeMultiprocessorCount, dev);
        if (hipFuncSetAttribute((const void*)mega_fwd, hipFuncAttributeMaxDynamicSharedMemorySize, LDS_BYTES) != hipSuccess) { fprintf(stderr, "kernel_launch: hipFuncSetAttribute failed\n"); grid = -1; return; }
        hipOccupancyMaxActiveBlocksPerMultiprocessor(&per_cu, (const void*)mega_fwd, 512, LDS_BYTES);
        (void)hipGetLastError();
        if (per_cu < 1) per_cu = 1;
        grid = cus * 1;
    }
    if (grid < 0) return;
    Params p{};
    const float** pp = (const float**)&p;
    for (int i = 0; i < 33; ++i) pp[i] = (const float*)d_in[i];
    p.out = (float*)d_out; p.ws = (unsigned char*)d_ws;
    void* args[] = {&p};
    hipError_t e = hipLaunchCooperativeKernel((const void*)mega_fwd, dim3(grid), dim3(512), args, LDS_BYTES, stream);
    if (e != hipSuccess) fprintf(stderr, "cooperative launch failed: %s (grid %d)\n", hipGetErrorString(e), grid);
}
```

```cpp
#include <hip/hip_runtime.h>
#include <hip/hip_cooperative_groups.h>
#include <cstdio>
namespace cg = cooperative_groups;

#define LAS __attribute__((address_space(3)))
typedef unsigned short u16;
typedef short bf16x8 __attribute__((ext_vector_type(8)));
typedef float f32x4 __attribute__((ext_vector_type(4)));
typedef float f32x2 __attribute__((ext_vector_type(2)));
typedef unsigned u32x4 __attribute__((ext_vector_type(4)));
typedef unsigned u32x2 __attribute__((ext_vector_type(2)));

constexpr int DM = 1024, NB = 16, SEQ = 4096, CTXL = 256;
constexpr int ML = NB * SEQ, MC = NB * CTXL, MT = ML + MC;
constexpr int FH = 2688, F2 = 5376;
constexpr int LDS_BYTES = 147456;
#ifndef PROBE_CLASS
#define PROBE_CLASS 0
#endif
#define XCD_REMAP 0

constexpr size_t SZ_FFN_UP_T = (size_t)F2 * 1024 * 2, SZ_FFN_DN_T = (size_t)1024 * FH * 2;
constexpr size_t WS_FFN_UP_T = 0;
constexpr size_t WS_FFN_DN_T = WS_FFN_UP_T + 4 * SZ_FFN_UP_T;
constexpr size_t WS_CM_IN_T = WS_FFN_DN_T + 4 * SZ_FFN_DN_T;
constexpr size_t WS_CM_OUT_T = WS_CM_IN_T + 2 * (size_t)4096 * 1024 * 2;
constexpr size_t WS_LRU_IN_T = WS_CM_OUT_T + 2 * (size_t)1024 * 2048 * 2;
constexpr size_t WS_LRU_G_T = WS_LRU_IN_T + (size_t)2048 * 1024 * 2;
constexpr size_t WS_LRU_OUT_T = WS_LRU_G_T + (size_t)4 * 1024 * 256 * 2;
constexpr size_t WS_ML_IN_T = WS_LRU_OUT_T + (size_t)1024 * 1024 * 2;
constexpr size_t WS_ML_OUT_T = WS_ML_IN_T + (size_t)3328 * 1024 * 2;
constexpr size_t WS_XC = WS_ML_OUT_T + (size_t)1024 * 1024 * 2;
constexpr size_t WS_MOD = WS_XC + (size_t)MC * 1024 * 4;
constexpr size_t WS_SEG = WS_MOD + (size_t)4 * 17 * 6144 * 4;
constexpr size_t WS_SP8 = WS_SEG + (size_t)2 * 544 * 1024 * 2 * 4;
constexpr size_t WS_RS = WS_SP8 + 8192;
constexpr size_t WS_SHW = WS_RS + (size_t)MT * 16 * 4;
constexpr int SHW_IN_OFF0 = 0, SHW_IN_OFF1 = 17 * 4096, SHW_IN_OFF2 = SHW_IN_OFF1 + 17 * 2048, SHW_IN_OFF3 = SHW_IN_OFF2 + 17 * 3328, SHW_UP_OFF = SHW_IN_OFF3 + 17 * 4096;
constexpr size_t WS_BAR = WS_SHW + (size_t)(SHW_UP_OFF + 4 * 17 * F2) * 4;
constexpr size_t WS_ACT = WS_BAR + 16384;
constexpr size_t SLOT = (size_t)MT * 1024 * 2;
constexpr size_t WS_END = WS_ACT + SLOT + (size_t)MT * 2816 * 2 + (size_t)MT * FH * 2;

struct Params {
    const float *x, *c, *ctx, *c_ctx, *norm1_g, *norm2_g, *mod_w, *mod_b, *ffn_w_up, *ffn_conv_w, *ffn_conv_b, *ffn_w_down,
        *cm_w_in, *cm_b_in, *cm_v_g, *cm_v_b, *cm_w_s, *cm_b_s, *cm_w_out, *lru_w_in, *lru_conv_w, *lru_conv_b, *lru_w_rg, *lru_b_rg,
        *lru_w_ig, *lru_b_ig, *lru_lambda, *lru_w_out, *ml_w_in, *ml_b_gate, *ml_norm_g, *ml_w_out, *final_norm_g;
    float* out; unsigned char* ws;
};

__device__ __forceinline__ unsigned cvt_pk_bf16(float lo, float hi) { unsigned r; asm volatile("v_cvt_pk_bf16_f32 %0, %1, %2" : "=v"(r) : "v"(lo), "v"(hi)); return r; }
__device__ __forceinline__ float bf_lo(unsigned w) { return __uint_as_float(w << 16); }
__device__ __forceinline__ float bf_hi(unsigned w) { return __uint_as_float(w & 0xffff0000u); }
__device__ __forceinline__ float bf2f(u16 b) { return __uint_as_float(((unsigned)b) << 16); }
__device__ __forceinline__ u16 f2bf(float f) { return (u16)(cvt_pk_bf16(f, 0.f) & 0xffffu); }
__device__ __forceinline__ float wave_sum(float v) {
#pragma unroll
    for (int o = 1; o < 64; o <<= 1) v += __shfl_xor(v, o);
    return v;
}
__device__ __forceinline__ float fexp_(float x) { return __builtin_amdgcn_exp2f(x * 1.4426950408889634f); }
__device__ __forceinline__ float sigmoidf_(float x) { return __builtin_amdgcn_rcpf(1.0f + fexp_(-x)); }
__device__ __forceinline__ float gelu_tanh(float x) { const float t = x * (1.5957691216f + 0.0713548163f * x * x); return x * __builtin_amdgcn_rcpf(1.0f + fexp_(-t)); }
__device__ __forceinline__ float siluf_(float x) { return x * __builtin_amdgcn_rcpf(1.0f + fexp_(-x)); }
__device__ __forceinline__ void unpack8(const u32x4 w, float (&f)[8]) {
    f[0] = bf_lo(w.x); f[1] = bf_hi(w.x); f[2] = bf_lo(w.y); f[3] = bf_hi(w.y); f[4] = bf_lo(w.z); f[5] = bf_hi(w.z); f[6] = bf_lo(w.w); f[7] = bf_hi(w.w);
}
__device__ __forceinline__ u32x4 pack8(const float (&f)[8]) {
    u32x4 w; w.x = cvt_pk_bf16(f[0], f[1]); w.y = cvt_pk_bf16(f[2], f[3]); w.z = cvt_pk_bf16(f[4], f[5]); w.w = cvt_pk_bf16(f[6], f[7]); return w;
}
#define BLOCK_SYNC() __syncthreads()
__device__ __forceinline__ size_t ablk(int row, int col, int KT) { return ((((size_t)(row >> 8) * KT + (col >> 6)) * 256 + (row & 255)) << 6) + (col & 63); }
__device__ __forceinline__ int obid() { int t = blockIdx.x; asm volatile("" : "+s"(t)); return t; }
__device__ __forceinline__ int ogdim() { int t = gridDim.x; asm volatile("" : "+s"(t)); return t; }
__device__ __forceinline__ int opaque_tid() { int t = threadIdx.x; asm volatile("" : "+v"(t)); return t; }

namespace g8 {
constexpr int BM = 256, BK = 64, HALF = 128, HTB = HALF * BK * 2, STAGE_BYTES = 8 * HTB, NXCD = 8, WGM = 8;
__device__ __forceinline__ int lds_byte(int r, int c) { const int st = (r >> 4) * 2 + (c >> 5), rr = r & 15, cc = c & 31, ob = rr * 64 + cc * 2; return st * 1024 + (ob ^ (((ob >> 9) & 1) << 5)); }
__device__ __forceinline__ void stage_rc(int b, int& R, int& C) { const int st = b / 1024, sb = b % 1024, swz = sb ^ (((sb >> 9) & 1) << 5); R = (st >> 1) * 16 + swz / 64; C = (st & 1) * 32 + (swz % 64) / 2; }
__device__ __forceinline__ int perm32(int rho) { const int n = rho >> 4, i = rho & 15; return 8 * (i >> 2) + 4 * n + (i & 3); }

struct Unit { int pm, pn, z; };
struct Desc { const u16* A; const u16* Bt; int lda, ldb, K, nM, nN, nZ, pm0, pn0; size_t zA, zB; int ablk; };

__device__ __forceinline__ bool next_unit(const Desc& g, int i, Unit& u) {
    const int nwg = g.nM * g.nN; const long L = (long)i * ogdim() + obid(); if (L >= (long)nwg * g.nZ) return false;
    u.z = (int)(L / nwg); int wgid = (int)(L % nwg);
#if XCD_REMAP
    { const int q = nwg / NXCD, r = nwg % NXCD, xcd = wgid % NXCD, off = wgid / NXCD; wgid = (xcd < r ? xcd * (q + 1) : r * (q + 1) + (xcd - r) * q) + off; }
#endif
    const int nig = WGM * g.nN, gid = wgid / nig, fm = gid * WGM, gsz = (g.nM - fm) < WGM ? (g.nM - fm) : WGM;
    u.pm = g.pm0 + fm + ((wgid % nig) % gsz); u.pn = g.pn0 + (wgid % nig) / gsz; return true;
}

template <class Epi>
__device__ __forceinline__ void gemm_phase(LAS unsigned char* lds, const Desc g, const Epi& E, unsigned long long& tepi, unsigned long long& g_ktiles) {
    const int tid = opaque_tid(), wid = __builtin_amdgcn_readfirstlane(tid >> 6), lane = tid & 63, wr = wid >> 2, wc = wid & 3, fr = lane & 15, fq = lane >> 4;
    const int K = g.K, nt = K / BK;
    unsigned voffA[2], voffB[2];
#pragma unroll
    for (int i = 0; i < 2; ++i) { int R, C; stage_rc(tid * 16 + i * 8192, R, C); const int Rb = Epi::PERM ? ((R & ~31) + perm32(R & 31)) : R;
        voffA[i] = g.ablk ? (unsigned)(R * 64 + C) * 2u : (unsigned)(R * g.lda + C) * 2u; voffB[i] = (unsigned)(Rb * g.ldb + C) * 2u; }
    const size_t kstepB = (size_t)(BK * 2), kstepA = g.ablk ? (size_t)(256 * BK * 2) : (size_t)(BK * 2);
    const size_t hstepA = g.ablk ? (size_t)(HALF * BK * 2) : (size_t)HALF * g.lda * 2, hstepB = (size_t)HALF * g.ldb * 2;
    const size_t tstepA = (size_t)256 * g.lda * 2, tstepB = 2 * hstepB;
    const unsigned ldsw = (unsigned)wid * 1024u;
    const int aoff = lds_byte(wr * 64 + fr, fq * 8), boff = lds_byte(wc * 32 + fr, fq * 8);
#define PG8_SA(b, h) (((b) * 2 + (h)) * HTB)
#define PG8_SB(b, h) ((4 + (b) * 2 + (h)) * HTB)
#define PG8_STAGE(bufoff, gbase, voff) do { _Pragma("unroll") for (int _i = 0; _i < 2; ++_i) \
        __builtin_amdgcn_global_load_lds((const unsigned*)((const char*)(gbase) + (voff)[_i]), (LAS unsigned*)(lds + (bufoff) + ldsw + _i * 8192), 16, 0, 0); } while (0)
#define PG8_LDA(dst, b, h) do { _Pragma("unroll") for (int m = 0; m < 4; ++m) _Pragma("unroll") for (int k = 0; k < 2; ++k) dst[m][k] = *(const LAS bf16x8*)(lds + PG8_SA(b, h) + aoff + m * 2048 + k * 1024); } while (0)
#define PG8_LDB(dst, b, h) do { _Pragma("unroll") for (int n = 0; n < 2; ++n) _Pragma("unroll") for (int k = 0; k < 2; ++k) dst[n][k] = *(const LAS bf16x8*)(lds + PG8_SB(b, h) + boff + n * 2048 + k * 1024); } while (0)
#define PG8_MMA(ai, bj, At, Bt) do { __builtin_amdgcn_s_setprio(1); _Pragma("unroll") for (int m = 0; m < 4; ++m) _Pragma("unroll") for (int n = 0; n < 2; ++n) _Pragma("unroll") for (int k = 0; k < 2; ++k) \
        acc[ai][bj][m][n] = __builtin_amdgcn_mfma_f32_16x16x32_bf16(Bt[n][k], At[m][k], acc[ai][bj][m][n], 0, 0, 0); __builtin_amdgcn_s_setprio(0); } while (0)
#define PG8_WAIT_V(n) asm volatile("s_waitcnt vmcnt(" #n ")" ::: "memory")
#define PG8_WAIT_L(n) asm volatile("s_waitcnt lgkmcnt(" #n ")" ::: "memory")
#define PG8_BAR __builtin_amdgcn_s_barrier()
#define PG8_SCHED __builtin_amdgcn_sched_barrier(0)
    Unit cur, nxt; int ui = 0;
    if (!next_unit(g, 0, cur)) return;
    f32x4 acc[2][2][4][2];
#pragma unroll
    for (int a = 0; a < 2; ++a)
#pragma unroll
        for (int b = 0; b < 2; ++b)
#pragma unroll
            for (int m = 0; m < 4; ++m)
#pragma unroll
                for (int n = 0; n < 2; ++n) acc[a][b][m][n] = (f32x4){0.f, 0.f, 0.f, 0.f};
    bf16x8 At[4][2], B0[2][2], B1[2][2];
    const char* cA = (const char*)g.A + ((size_t)cur.z * g.zA) * 2 + (size_t)cur.pm * tstepA;
    const char* cB = (const char*)g.Bt + ((size_t)cur.z * g.zB) * 2 + (size_t)cur.pn * tstepB;
    PG8_STAGE(PG8_SB(0, 0), cB, voffB); PG8_STAGE(PG8_SB(0, 1), cB + hstepB, voffB); PG8_STAGE(PG8_SA(0, 0), cA, voffA); PG8_STAGE(PG8_SA(0, 1), cA + hstepA, voffA);
    if (wr == 1) PG8_BAR;
    PG8_WAIT_V(2); PG8_BAR;
    PG8_STAGE(PG8_SB(1, 0), cB + kstepB, voffB); PG8_STAGE(PG8_SA(1, 0), cA + kstepA, voffA); PG8_STAGE(PG8_SB(1, 1), cB + hstepB + kstepB, voffB);
    PG8_WAIT_V(6); PG8_BAR;
    for (;;) {
        const bool has_next = next_unit(g, ui + 1, nxt);
        const char* nA = has_next ? (const char*)g.A + ((size_t)nxt.z * g.zA) * 2 + (size_t)nxt.pm * tstepA : cA;
        const char* nB = has_next ? (const char*)g.Bt + ((size_t)nxt.z * g.zB) * 2 + (size_t)nxt.pn * tstepB : cB;
        unsigned long long kc0 = 0; if (PROBE_CLASS == 9 || PROBE_CLASS == 11 || PROBE_CLASS == 12) kc0 = clock64();
        for (int t = 0; t < nt; t += 2) {
            const bool last = (t == nt - 2);
            const char* a1 = cA + (size_t)(t + 1) * kstepA;
            const char* a2 = last ? nA : cA + (size_t)(t + 2) * kstepA; const char* b2 = last ? nB : cB + (size_t)(t + 2) * kstepB;
            const char* a3 = a2 + kstepA; const char* b3 = b2 + kstepB;
            PG8_LDB(B0, 0, 0); PG8_LDB(B1, 0, 1); PG8_SCHED; PG8_LDA(At, 0, 0); PG8_STAGE(PG8_SA(1, 1), a1 + hstepA, voffA);
            PG8_WAIT_V(8); PG8_WAIT_L(0); PG8_BAR; PG8_MMA(0, 0, At, B0); PG8_MMA(0, 1, At, B1); PG8_BAR; PG8_SCHED;
            PG8_LDA(At, 0, 1); PG8_STAGE(PG8_SB(0, 0), b2, voffB); PG8_STAGE(PG8_SB(0, 1), b2 + hstepB, voffB); PG8_STAGE(PG8_SA(0, 0), a2, voffA);
            PG8_WAIT_V(8); PG8_WAIT_L(0); PG8_BAR; PG8_MMA(1, 0, At, B0); PG8_MMA(1, 1, At, B1); PG8_BAR; PG8_SCHED;
            PG8_LDB(B0, 1, 0); PG8_LDB(B1, 1, 1); PG8_SCHED; PG8_LDA(At, 1, 0); PG8_STAGE(PG8_SA(0, 1), a2 + hstepA, voffA);
            PG8_WAIT_V(8); PG8_WAIT_L(0); PG8_BAR; PG8_MMA(0, 0, At, B0); PG8_MMA(0, 1, At, B1); PG8_BAR; PG8_SCHED;
            PG8_LDA(At, 1, 1); PG8_STAGE(PG8_SB(1, 0), b3, voffB); PG8_STAGE(PG8_SB(1, 1), b3 + hstepB, voffB); PG8_STAGE(PG8_SA(1, 0), a3, voffA);
            PG8_WAIT_V(8); PG8_WAIT_L(0); PG8_BAR; PG8_MMA(1, 0, At, B0); PG8_MMA(1, 1, At, B1); PG8_BAR; PG8_SCHED;
        }
        if (PROBE_CLASS == 9 || (PROBE_CLASS == 11 && ui == 0) || (PROBE_CLASS == 12 && ui >= 3)) { tepi += (clock64() - kc0); g_ktiles += nt; }
        if (wr == 0) PG8_BAR;
        if (PROBE_CLASS == 8) { const unsigned long long e0 = wall_clock64(); E(acc, cur, wr, wc, fr, fq); asm volatile("s_waitcnt vmcnt(0)" ::: "memory"); tepi += wall_clock64() - e0; } else E(acc, cur, wr, wc, fr, fq);
        if (!has_next) break;
#pragma unroll
        for (int a = 0; a < 2; ++a)
#pragma unroll
            for (int b = 0; b < 2; ++b)
#pragma unroll
                for (int m = 0; m < 4; ++m)
#pragma unroll
                    for (int n = 0; n < 2; ++n) acc[a][b][m][n] = (f32x4){0.f, 0.f, 0.f, 0.f};
        cur = nxt; cA = nA; cB = nB; ++ui;
        if (wr == 1) PG8_BAR;
    }
    PG8_WAIT_V(0);
    PG8_BAR;
#undef PG8_SA
#undef PG8_SB
#undef PG8_STAGE
#undef PG8_LDA
#undef PG8_LDB
#undef PG8_MMA
#undef PG8_WAIT_V
#undef PG8_WAIT_L
#undef PG8_BAR
#undef PG8_SCHED
}
}

__device__ __forceinline__ void rows_rstd(const float* rs, int row0, int fq, float (&rstd)[2][4]) {
    f32x4 pr[2][4];
#pragma unroll
    for (int ai = 0; ai < 2; ++ai)
#pragma unroll
        for (int m = 0; m < 4; ++m) pr[ai][m] = *(const f32x4*)(rs + (size_t)(row0 + ai * 128 + m * 16) * 16 + 4 * fq);
#pragma unroll
    for (int ai = 0; ai < 2; ++ai)
#pragma unroll
        for (int m = 0; m < 4; ++m) { float s = (pr[ai][m].x + pr[ai][m].y) + (pr[ai][m].z + pr[ai][m].w); s += __shfl_xor(s, 16); s += __shfl_xor(s, 32);
            rstd[ai][m] = __builtin_amdgcn_rsqf(s * (1.0f / 1024.0f) + 1e-6f); }
}
enum { M_BF16 = 0, M_CMIN = 1, M_RES = 2, M_LRUIN = 3, M_LRUG = 4, M_MLIN = 5 };
struct EP {
    u16 *o0, *o1, *o2, *o3; float* f0;
    const float *xsl, *xsc; float *xdl, *xdc;
    const float *gate, *bias, *q0, *q1, *q2; const u16* bsrc;
    int ldc, pn0;
    const float *ng, *nsc; u16* xb; float* rs;
    const float *rsr, *shw; int shwld;
};
template <int MODE> struct Epi {
    static constexpr bool PERM = (MODE != M_RES);
    EP p;
    __device__ __forceinline__ void operator()(const f32x4 (&acc)[2][2][4][2], const g8::Unit& u, int wr, int wc, int fr, int fq) const {
        const int row0 = u.pm * 256 + wr * 64 + fr;
        if constexpr (MODE == M_RES) {
            const int col0 = u.pn * 256 + wc * 32 + 4 * fq;
            const bool lat = u.pm < 256; const int mb = lat ? (u.pm >> 4) : 16;
            const float* gp = p.gate + (size_t)mb * 6144 + col0;
            const bool wxb = p.xb != nullptr;
            f32x4 gv[2][2], gm[2][2];
#pragma unroll
            for (int bj = 0; bj < 2; ++bj)
#pragma unroll
                for (int n = 0; n < 2; ++n) { gv[bj][n] = *(const f32x4*)(gp + bj * 128 + n * 16);
                    if (wxb) { const f32x4 g4 = *(const f32x4*)(p.ng + col0 + bj * 128 + n * 16), s4 = *(const f32x4*)(p.nsc + (size_t)mb * 6144 + col0 + bj * 128 + n * 16); gm[bj][n] = g4 * (s4 + 1.0f); }
                    else gm[bj][n] = (f32x4){0.f, 0.f, 0.f, 0.f}; }
            const float* xs = lat ? p.xsl : p.xsc; float* xd = lat ? p.xdl : p.xdc; const int rbase = lat ? row0 : row0 - ML;
#pragma unroll
            for (int ai2 = 0; ai2 < 4; ++ai2) { const int ai = ai2 >> 1, mb0 = (ai2 & 1) * 2;
                f32x4 xv[4][2][2];
#pragma unroll
                for (int m = mb0; m < mb0 + 2; ++m) { const size_t off = (size_t)(rbase + ai * 128 + m * 16) * 1024 + col0;
#pragma unroll
                    for (int bj = 0; bj < 2; ++bj)
#pragma unroll
                        for (int n = 0; n < 2; ++n) xv[m][bj][n] = *(const f32x4*)(xs + off + bj * 128 + n * 16); }
#pragma unroll
                for (int m = mb0; m < mb0 + 2; ++m) { const size_t off = (size_t)(rbase + ai * 128 + m * 16) * 1024 + col0; const int row = row0 + ai * 128 + m * 16; float ssq = 0.f;
#pragma unroll
                    for (int bj = 0; bj < 2; ++bj)
#pragma unroll
                        for (int n = 0; n < 2; ++n) { const f32x4 xn = xv[m][bj][n] + gv[bj][n] * acc[ai][bj][m][n];
                            *(f32x4*)(xd + off + bj * 128 + n * 16) = xn;
                            if (wxb) { ssq += (xn.x * xn.x + xn.y * xn.y) + (xn.z * xn.z + xn.w * xn.w); const f32x4 hb = xn * gm[bj][n];
                                u32x2 o; o.x = cvt_pk_bf16(hb.x, hb.y); o.y = cvt_pk_bf16(hb.z, hb.w); *(u32x2*)(p.xb + ablk(row, col0 + bj * 128 + n * 16, 16)) = o; } }
                    if (wxb) { ssq += __shfl_xor(ssq, 16); ssq += __shfl_xor(ssq, 32); if (fq == 0) p.rs[(size_t)row * 16 + u.pn * 4 + wc] = ssq; } }
            }
        } else if constexpr (MODE == M_BF16) {
            const int col0 = (u.pn - p.pn0) * 256 + wc * 32 + 8 * fq, colg = u.pn * 256 + wc * 32 + 8 * fq;
            const int mb = u.pm < 256 ? (u.pm >> 4) : 16;
            f32x4 sv[2][2];
#pragma unroll
            for (int bj = 0; bj < 2; ++bj)
#pragma unroll
                for (int n = 0; n < 2; ++n) sv[bj][n] = *(const f32x4*)(p.shw + (size_t)mb * p.shwld + colg + bj * 128 + 4 * n);
float rstd8[2][4]; rows_rstd(p.rsr, row0, fq, rstd8);
#pragma unroll
            for (int ai = 0; ai < 2; ++ai)
#pragma unroll
                for (int m = 0; m < 4; ++m) { const int row = row0 + ai * 128 + m * 16; const float rstd = rstd8[ai][m]; const int tjl = u.pn - p.pn0, cin = (wc & 1) * 32 + 8 * fq;
#pragma unroll
                    for (int bj = 0; bj < 2; ++bj) { const f32x4 v0 = acc[ai][bj][m][0] * rstd + sv[bj][0], v1 = acc[ai][bj][m][1] * rstd + sv[bj][1];
                        u32x4 w; w.x = cvt_pk_bf16(v0[0], v0[1]); w.y = cvt_pk_bf16(v0[2], v0[3]); w.z = cvt_pk_bf16(v1[0], v1[1]); w.w = cvt_pk_bf16(v1[2], v1[3]);
                        *(u32x4*)(p.o0 + (((size_t)(tjl * 4 + 2 * bj + (wc >> 1)) * MT + row) << 6) + cin) = w; } }
        } else if constexpr (MODE == M_CMIN) {
            const int colg = u.pn * 256 + wc * 32 + 8 * fq;
            const bool isv = u.pn >= 8; u16* base = isv ? p.o1 : p.o0; const int colt = colg - (isv ? 2048 : 0);
            f32x4 bv[2][2];
#pragma unroll
            for (int bj = 0; bj < 2; ++bj)
#pragma unroll
                for (int n = 0; n < 2; ++n) bv[bj][n] = *(const f32x4*)(p.bias + colg + bj * 128 + 4 * n) + *(const f32x4*)(p.shw + (size_t)(u.pm < 256 ? (u.pm >> 4) : 16) * p.shwld + colg + bj * 128 + 4 * n);
float rstd8[2][4]; rows_rstd(p.rsr, row0, fq, rstd8);
#pragma unroll
            for (int ai = 0; ai < 2; ++ai)
#pragma unroll
                for (int m = 0; m < 4; ++m) { const int row = row0 + ai * 128 + m * 16; const float rstd = rstd8[ai][m]; u16* rp = base + (size_t)row * 2048 + colt; float s = 0.f, ss = 0.f;
#pragma unroll
                    for (int bj = 0; bj < 2; ++bj) { f32x4 v0 = acc[ai][bj][m][0] * rstd + bv[bj][0], v1 = acc[ai][bj][m][1] * rstd + bv[bj][1];
#pragma unroll
                        for (int e = 0; e < 4; ++e) { v0[e] = gelu_tanh(v0[e]); v1[e] = gelu_tanh(v1[e]); s += v0[e] + v1[e]; ss += v0[e] * v0[e] + v1[e] * v1[e]; }
                        u32x4 w; w.x = cvt_pk_bf16(v0[0], v0[1]); w.y = cvt_pk_bf16(v0[2], v0[3]); w.z = cvt_pk_bf16(v1[0], v1[1]); w.w = cvt_pk_bf16(v1[2], v1[3]);
                        *(u32x4*)(rp + bj * 128) = w; }
                    if (isv) { s += __shfl_xor(s, 16); s += __shfl_xor(s, 32); ss += __shfl_xor(ss, 16); ss += __shfl_xor(ss, 32);
                        if (fq == 0) *(f32x2*)(p.f0 + ((size_t)row * 32 + (u.pn - 8) * 4 + wc) * 2) = (f32x2){s, ss}; } }
        } else if constexpr (MODE == M_LRUIN) {
            const int colg = u.pn * 256 + wc * 32 + 8 * fq;
            const bool isx = u.pn >= 4; u16* base = isx ? p.o1 : p.o0; const int colt = colg - (isx ? 1024 : 0);
            const int mb = u.pm < 256 ? (u.pm >> 4) : 16;
            f32x4 sv[2][2];
#pragma unroll
            for (int bj = 0; bj < 2; ++bj)
#pragma unroll
                for (int n = 0; n < 2; ++n) sv[bj][n] = *(const f32x4*)(p.shw + (size_t)mb * p.shwld + colg + bj * 128 + 4 * n);
float rstd8[2][4]; rows_rstd(p.rsr, row0, fq, rstd8);
#pragma unroll
            for (int ai = 0; ai < 2; ++ai)
#pragma unroll
                for (int m = 0; m < 4; ++m) { const int row = row0 + ai * 128 + m * 16; const float rstd = rstd8[ai][m]; u16* rp = base + (size_t)row * 1024 + colt;
#pragma unroll
                    for (int bj = 0; bj < 2; ++bj) { f32x4 v0 = acc[ai][bj][m][0] * rstd + sv[bj][0], v1 = acc[ai][bj][m][1] * rstd + sv[bj][1];
                        if (!isx) {
#pragma unroll
                            for (int e = 0; e < 4; ++e) { v0[e] = gelu_tanh(v0[e]); v1[e] = gelu_tanh(v1[e]); } }
                        u32x4 w; w.x = cvt_pk_bf16(v0[0], v0[1]); w.y = cvt_pk_bf16(v0[2], v0[3]); w.z = cvt_pk_bf16(v1[0], v1[1]); w.w = cvt_pk_bf16(v1[2], v1[3]);
                        *(u32x4*)(rp + bj * 128) = w; } }
        } else if constexpr (MODE == M_LRUG) {
            const int h = u.z, d = u.pn >> 1, jb = u.pn & 1;
            const int ch = h * 256 + jb * 128 + wc * 32 + 8 * fq;
            u16* la = p.o0 + (size_t)d * (4 * (SLOT / 2)); u16* bo = p.o1 + (size_t)d * (3 * (SLOT / 2));
#pragma unroll
            for (int n = 0; n < 2; ++n) {
                const int c4 = ch + 4 * n;
                const f32x4 brg = *(const f32x4*)(p.q0 + d * 1024 + c4), big = *(const f32x4*)(p.q1 + d * 1024 + c4), sp4 = *(const f32x4*)(p.q2 + d * 1024 + c4);
#pragma unroll
                for (int ai = 0; ai < 2; ++ai) {
                    u32x2 xr4[4];
#pragma unroll
                    for (int m = 0; m < 4; ++m) xr4[m] = *(const u32x2*)(p.bsrc + (size_t)(row0 + ai * 128 + m * 16) * 1024 + c4);
#pragma unroll
                    for (int m = 0; m < 4; ++m) { const size_t off = (size_t)(row0 + ai * 128 + m * 16) * 1024 + c4;
                        const u32x2 xr = xr4[m]; const float xv[4] = {bf_lo(xr.x), bf_hi(xr.x), bf_lo(xr.y), bf_hi(xr.y)};
                        float lo[4], bb[4];
#pragma unroll
                        for (int e = 0; e < 4; ++e) { const float r = sigmoidf_(acc[ai][0][m][n][e] + brg[e]), ig = sigmoidf_(acc[ai][1][m][n][e] + big[e]);
                            const float lg = -sp4[e] * r; lo[e] = lg; bb[e] = __builtin_amdgcn_sqrtf(fmaxf(1.0f - fexp_(2.0f * lg), 0.f)) * ig * xv[e]; }
                        u32x2 o1; o1.x = cvt_pk_bf16(lo[0], lo[1]); o1.y = cvt_pk_bf16(lo[2], lo[3]); *(u32x2*)(la + off) = o1;
                        u32x2 o2; o2.x = cvt_pk_bf16(bb[0], bb[1]); o2.y = cvt_pk_bf16(bb[2], bb[3]); *(u32x2*)(bo + off) = o2; }
                }
            }
        } else if constexpr (MODE == M_MLIN) {
            const int colg = u.pn * 256 + wc * 32 + 8 * fq;
            const int reg = u.pn < 2 ? 0 : (u.pn < 4 ? 1 : (u.pn < 8 ? 2 : (u.pn < 12 ? 3 : 4)));
            u16* base = reg == 0 ? p.o0 : (reg == 1 ? p.o1 : (reg == 2 ? p.o2 : p.o3));
            const int ld = (reg < 2) ? 512 : 1024; const int colt = colg - (reg == 0 ? 0 : (reg == 1 ? 512 : (reg == 2 ? 1024 : 2048)));
            const int mb = u.pm < 256 ? (u.pm >> 4) : 16;
            f32x4 sv[2][2];
#pragma unroll
            for (int bj = 0; bj < 2; ++bj)
#pragma unroll
                for (int n = 0; n < 2; ++n) sv[bj][n] = *(const f32x4*)(p.shw + (size_t)mb * p.shwld + colg + bj * 128 + 4 * n);
float rstd8[2][4]; rows_rstd(p.rsr, row0, fq, rstd8);
#pragma unroll
            for (int ai = 0; ai < 2; ++ai)
#pragma unroll
                for (int m = 0; m < 4; ++m) { const int row = row0 + ai * 128 + m * 16; const float rstd = rstd8[ai][m];
                    if (reg < 4) { u16* rp = base + (size_t)row * ld + colt;
#pragma unroll
                        for (int bj = 0; bj < 2; ++bj) { f32x4 v0 = acc[ai][bj][m][0] * rstd + sv[bj][0], v1 = acc[ai][bj][m][1] * rstd + sv[bj][1];
                            if (reg == 0) { v0 = v0 * 0.08838834764831845f; v1 = v1 * 0.08838834764831845f; }
                            if (reg == 3) {
#pragma unroll
                                for (int e = 0; e < 4; ++e) { v0[e] = sigmoidf_(v0[e]); v1[e] = sigmoidf_(v1[e]); } }
                            u32x4 w; w.x = cvt_pk_bf16(v0[0], v0[1]); w.y = cvt_pk_bf16(v0[2], v0[3]); w.z = cvt_pk_bf16(v1[0], v1[1]); w.w = cvt_pk_bf16(v1[2], v1[3]);
                            *(u32x4*)(rp + bj * 128) = w; }
                    } else {
                        const int cl = wc * 32 + 8 * fq;
                        if (cl < 16) {
#pragma unroll
                            for (int e = 0; e < 8; ++e) p.f0[(size_t)row * 16 + cl + e] = acc[ai][0][m][e >> 2][e & 3] * rstd + sv[0][e >> 2][e & 3] + p.bias[cl + e]; }
                    } }
        }
    }
};

__device__ __forceinline__ void tr_item(const float* src, int ld, int nvalid, u16* dst, int ldd, LAS float* scr, int lane) {
#pragma unroll
    for (int i = 0; i < 8; ++i) { const int kk = 8 * i + (lane >> 3), c4 = (lane & 7) * 4;
        const f32x4 v = (c4 < nvalid) ? *(const f32x4*)(src + (size_t)kk * ld + c4) : (f32x4){0.f, 0.f, 0.f, 0.f};
        scr[kk * 33 + c4] = v.x; scr[kk * 33 + c4 + 1] = v.y; scr[kk * 33 + c4 + 2] = v.z; scr[kk * 33 + c4 + 3] = v.w; }
    asm volatile("s_waitcnt lgkmcnt(0)" ::: "memory");
    const int c = lane & 7;
#pragma unroll
    for (int j = 0; j < 4; ++j) { const int n = (lane >> 3) + 8 * j; const LAS float* s = scr + (8 * c) * 33 + n;
        u32x4 o; o.x = cvt_pk_bf16(s[0 * 33], s[1 * 33]); o.y = cvt_pk_bf16(s[2 * 33], s[3 * 33]); o.z = cvt_pk_bf16(s[4 * 33], s[5 * 33]); o.w = cvt_pk_bf16(s[6 * 33], s[7 * 33]);
        *(u32x4*)(dst + (size_t)n * ldd + 8 * c) = o; }
    asm volatile("s_waitcnt lgkmcnt(0)" ::: "memory");
}
template <int MAP> __device__ __forceinline__ void transpose_w(const float* src, int K, int ldsrc, int nsrc, u16* dst, int ndst, LAS float* scr, int gw, int ngw, int lane) {
    const int nkb = K / 64, nitems = (ndst / 32) * nkb;
    for (int it = gw; it < nitems; it += ngw) {
        const int nb = it / nkb, kb = it % nkb, n0 = nb * 32, k0 = kb * 64;
        int c0 = n0;
        if (MAP == 1) { const int j = n0 >> 8, w = n0 & 255, q = w >> 6, r = w & 63; c0 = (r < 32) ? (j * 128 + 32 * q) : (FH + j * 128 + 32 * q); }
        int nvalid = nsrc - c0; nvalid = nvalid > 32 ? 32 : nvalid;
        tr_item(src + (size_t)k0 * ldsrc + c0, ldsrc, nvalid, dst + (size_t)n0 * K + k0, K, scr, lane);
    }
}

__device__ __forceinline__ void phase_prologue(LAS unsigned char* lds, const Params& P) {
    const int tid = opaque_tid(), lane = tid & 63, wid = tid >> 6, bid = obid(), nb = ogdim();
    unsigned char* ws = P.ws;
    {
        LAS float* sl = (LAS float*)lds;
        LAS float* red = sl + 17 * 1024;
        for (int i = tid; i < 17 * 1024; i += 512) { const int mb = i >> 10, k = i & 1023; const float v = mb < 16 ? P.c[mb * 1024 + k] : P.c_ctx[k]; sl[i] = siluf_(v); }
        BLOCK_SYNC();
        float* MOD = (float*)(ws + WS_MOD);
        for (int item = bid; item < 4 * 96; item += nb) {
            const int l = item / 96, n0 = (item % 96) * 64, col = tid & 63, kg = tid >> 6;
            float a[17];
#pragma unroll
            for (int i = 0; i < 17; ++i) a[i] = 0.f;
            const float* w = P.mod_w + ((size_t)l * 1024 + kg * 128) * 6144 + n0 + col;
            for (int kk = 0; kk < 128; ++kk) { const float wv = w[(size_t)kk * 6144];
#pragma unroll
                for (int i = 0; i < 17; ++i) a[i] += sl[i * 1024 + kg * 128 + kk] * wv; }
#pragma unroll
            for (int i = 0; i < 17; ++i) red[(kg * 17 + i) * 64 + col] = a[i];
            BLOCK_SYNC();
            for (int o = tid; o < 17 * 64; o += 512) { const int mb = o >> 6, cc = o & 63; float s = P.mod_b[l * 6144 + n0 + cc];
#pragma unroll
                for (int k8 = 0; k8 < 8; ++k8) s += red[(k8 * 17 + mb) * 64 + cc];
                MOD[((size_t)l * 17 + mb) * 6144 + n0 + cc] = s; }
            BLOCK_SYNC();
        }
    }
    BLOCK_SYNC();
    for (int i = bid * 512 + tid; i < 2048; i += nb * 512) ((float*)(ws + WS_SP8))[i] = 8.0f * log1pf(__expf(-P.lru_lambda[i]));
    LAS float* scr = (LAS float*)(lds + wid * 8448);
    const int gw = bid * 8 + wid, ngw = nb * 8;
    for (int l = 0; l < 4; ++l) {
        transpose_w<1>(P.ffn_w_up + (size_t)l * 1024 * F2, 1024, F2, F2, (u16*)(ws + WS_FFN_UP_T + l * SZ_FFN_UP_T), F2, scr, gw, ngw, lane);
        transpose_w<0>(P.ffn_w_down + (size_t)l * FH * 1024, FH, 1024, 1024, (u16*)(ws + WS_FFN_DN_T + l * SZ_FFN_DN_T), 1024, scr, gw, ngw, lane);
    }
    for (int j = 0; j < 2; ++j) {
        transpose_w<0>(P.cm_w_in + (size_t)j * 1024 * 4096, 1024, 4096, 4096, (u16*)(ws + WS_CM_IN_T) + (size_t)j * 4096 * 1024, 4096, scr, gw, ngw, lane);
        transpose_w<0>(P.cm_w_out + (size_t)j * 2048 * 1024, 2048, 1024, 1024, (u16*)(ws + WS_CM_OUT_T) + (size_t)j * 1024 * 2048, 1024, scr, gw, ngw, lane);
    }
    transpose_w<0>(P.lru_w_in, 1024, 2048, 2048, (u16*)(ws + WS_LRU_IN_T), 2048, scr, gw, ngw, lane);
    transpose_w<0>(P.lru_w_out, 1024, 1024, 1024, (u16*)(ws + WS_LRU_OUT_T), 1024, scr, gw, ngw, lane);
    transpose_w<0>(P.ml_w_in, 1024, 3088, 3088, (u16*)(ws + WS_ML_IN_T), 3328, scr, gw, ngw, lane);
    transpose_w<0>(P.ml_w_out, 1024, 1024, 1024, (u16*)(ws + WS_ML_OUT_T), 1024, scr, gw, ngw, lane);
    for (int q = 0; q < 32; ++q) {
        const int h = q >> 3, tn = (q >> 1) & 3, gate = q & 1, d = tn >> 1, jb = tn & 1;
        const float* src = (gate ? P.lru_w_ig : P.lru_w_rg) + (size_t)(d * 4 + h) * 256 * 256 + jb * 128;
        u16* dst = (u16*)(ws + WS_LRU_G_T) + ((size_t)h * 1024 + tn * 256 + gate * 128) * 256;
        transpose_w<0>(src, 256, 256, 128, dst, 128, scr, (gw + q * 16) % ngw, ngw, lane);
    }
}

__device__ __forceinline__ void phase_prenorm(const float* xl, const float* xc, const float* g, const float* modl, int shoff, int scoff, u16* H, int nrows) {
    const int tid_ = opaque_tid(); const int lane = tid_ & 63, gw = obid() * 8 + (tid_ >> 6), ngw = ogdim() * 8;
    for (int r = gw; r < nrows; r += ngw) {
        const bool lat = r < ML; const float* xr = lat ? xl + (size_t)r * 1024 : xc + (size_t)(r - ML) * 1024; const int mb = lat ? (r >> 12) : 16;
        f32x4 v[4]; float ss = 0.f;
#pragma unroll
        for (int j = 0; j < 4; ++j) { v[j] = ((const f32x4*)xr)[lane + 64 * j]; ss += (v[j].x * v[j].x + v[j].y * v[j].y) + (v[j].z * v[j].z + v[j].w * v[j].w); }
        const float rstd = rsqrtf(wave_sum(ss) * (1.0f / 1024.0f) + 1e-6f);
        const float* mp = modl + (size_t)mb * 6144;
#pragma unroll
        for (int j = 0; j < 4; ++j) { const int c = (lane + 64 * j) * 4;
            const f32x4 gg = *(const f32x4*)(g + c), sc = *(const f32x4*)(mp + scoff + c), sh = *(const f32x4*)(mp + shoff + c);
            const f32x4 y = v[j] * rstd * gg; const f32x4 hh = y * (sc + 1.0f) + sh;
            u32x2 o; o.x = cvt_pk_bf16(hh.x, hh.y); o.y = cvt_pk_bf16(hh.z, hh.w);
            *(u32x2*)(H + (size_t)r * 1024 + c) = o; }
    }
}
__device__ __forceinline__ void phase_pre0(const float* xl, const float* xc, const float* g, const float* modl, int scoff, u16* XB, float* RS, int nrows) {
    const int tid_ = opaque_tid(); const int lane = tid_ & 63, gw = obid() * 8 + (tid_ >> 6), ngw = ogdim() * 8;
    for (int r = gw; r < nrows; r += ngw) {
        const bool lat = r < ML; const float* xr = lat ? xl + (size_t)r * 1024 : xc + (size_t)(r - ML) * 1024; const int mb = lat ? (r >> 12) : 16;
        f32x4 v[4]; float ss = 0.f;
#pragma unroll
        for (int j = 0; j < 4; ++j) { v[j] = ((const f32x4*)xr)[lane + 64 * j]; ss += (v[j].x * v[j].x + v[j].y * v[j].y) + (v[j].z * v[j].z + v[j].w * v[j].w); }
        ss = wave_sum(ss);
        if (lane < 16) RS[(size_t)r * 16 + lane] = (lane == 0) ? ss : 0.f;
        const float* mp = modl + (size_t)mb * 6144;
#pragma unroll
        for (int j = 0; j < 4; ++j) { const int c = (lane + 64 * j) * 4;
            const f32x4 gg = *(const f32x4*)(g + c), sc = *(const f32x4*)(mp + scoff + c);
            const f32x4 hh = v[j] * gg * (sc + 1.0f);
            u32x2 o; o.x = cvt_pk_bf16(hh.x, hh.y); o.y = cvt_pk_bf16(hh.z, hh.w);
            *(u32x2*)(XB + ablk(r, c, 16)) = o; }
    }
}
__device__ __forceinline__ void shw_table(LAS unsigned char* lds, const float* modl, int shoff, const u16* Wt, int N, float* out) {
    LAS float* sh = (LAS float*)lds;
    const int tid = opaque_tid(), lane = tid & 63, wid = tid >> 6;
    BLOCK_SYNC();
    for (int i = tid; i < 17 * 1024; i += 512) sh[i] = modl[(size_t)(i >> 10) * 6144 + shoff + (i & 1023)];
    BLOCK_SYNC();
    for (int n = obid() * 8 + wid; n < N; n += ogdim() * 8) {
        float w[16]; { float t8[8]; unpack8(*(const u32x4*)(Wt + (size_t)n * 1024 + lane * 8), t8);
#pragma unroll
            for (int e = 0; e < 8; ++e) w[e] = t8[e];
            unpack8(*(const u32x4*)(Wt + (size_t)n * 1024 + 512 + lane * 8), t8);
#pragma unroll
            for (int e = 0; e < 8; ++e) w[8 + e] = t8[e]; }
        float res = 0.f;
#pragma unroll 1
        for (int mb = 0; mb < 17; ++mb) { const LAS float* s = sh + mb * 1024 + lane * 8; float a = 0.f;
#pragma unroll
            for (int e = 0; e < 8; ++e) a += w[e] * s[e] + w[8 + e] * s[512 + e];
            a = wave_sum(a); if (lane == mb) res = a; }
        if (lane < 17) out[(size_t)lane * N + n] = res;
    }
}
__device__ __forceinline__ void phase_final_norm(float* x, const float* g) {
    const int tid_ = opaque_tid(); const int lane = tid_ & 63, gw = obid() * 8 + (tid_ >> 6), ngw = ogdim() * 8;
    for (int r = gw; r < ML; r += ngw) {
        float* xr = x + (size_t)r * 1024; f32x4 v[4]; float ss = 0.f;
#pragma unroll
        for (int j = 0; j < 4; ++j) { v[j] = ((const f32x4*)xr)[lane + 64 * j]; ss += (v[j].x * v[j].x + v[j].y * v[j].y) + (v[j].z * v[j].z + v[j].w * v[j].w); }
        const float rstd = rsqrtf(wave_sum(ss) * (1.0f / 1024.0f) + 1e-6f);
#pragma unroll
        for (int j = 0; j < 4; ++j) { const int c = (lane + 64 * j) * 4; const f32x4 gg = *(const f32x4*)(g + c); ((f32x4*)xr)[lane + 64 * j] = v[j] * rstd * gg; }
    }
}

__device__ __forceinline__ void phase_cm_spatial(LAS unsigned char* lds, u16* U, const u16* V, const float* pstats, const float* w_s, const float* b_s, const float* v_g, const float* v_b, int nchunks) {
    constexpr int LW = 136;
    LAS u16* VT = (LAS u16*)lds;
    LAS u16* WP = (LAS u16*)(lds + 69632);
    LAS float* mu = (LAS float*)(lds + 104448); LAS float* rs = mu + 128; LAS float* t1 = rs + 128; LAS float* t2 = t1 + 128;
    const int tid = opaque_tid(), lane = tid & 63, w = tid >> 6, fr = lane & 15, fq = lane >> 4;
    for (int item = obid(); item < nchunks * 8; item += ogdim()) {
        const int ck = item >> 3, g = item & 7, r0 = ck * 128;
        if (tid < 128) { const float* ps = pstats + (size_t)(r0 + tid) * 64; float s = 0.f, ss = 0.f;
            for (int i = 0; i < 32; ++i) { s += ps[2 * i]; ss += ps[2 * i + 1]; }
            const float mean = s * (1.0f / 2048.0f); const float var = fmaxf(ss * (1.0f / 2048.0f) - mean * mean, 0.f);
            mu[tid] = mean; rs[tid] = rsqrtf(var + 1e-6f); }
        BLOCK_SYNC();
#pragma unroll
        for (int j = 0; j < 8; ++j) { const int pc = tid + 512 * j, q = pc & 127, c8 = pc >> 7;
            const u32x4 raw = *(const u32x4*)(V + (size_t)(r0 + q) * 2048 + g * 256 + c8 * 8);
            LAS u16* d = VT + (c8 * 8) * LW + q;
            d[0 * LW] = (u16)(raw.x & 0xffffu); d[1 * LW] = (u16)(raw.x >> 16); d[2 * LW] = (u16)(raw.y & 0xffffu); d[3 * LW] = (u16)(raw.y >> 16);
            d[4 * LW] = (u16)(raw.z & 0xffffu); d[5 * LW] = (u16)(raw.z >> 16); d[6 * LW] = (u16)(raw.w & 0xffffu); d[7 * LW] = (u16)(raw.w >> 16); }
        { const int pr = tid >> 2, part = tid & 3; const float* wrow = w_s + ((size_t)g * 128 + pr) * 128 + part * 32; float a1 = 0.f, a2 = 0.f;
            f32x4 wv4[8];
#pragma unroll
            for (int q4 = 0; q4 < 8; ++q4) wv4[q4] = ((const f32x4*)wrow)[q4];
#pragma unroll
            for (int q4 = 0; q4 < 8; ++q4) { const int q = part * 32 + q4 * 4; const f32x4 r4 = *(const LAS f32x4*)(rs + q), m4 = *(const LAS f32x4*)(mu + q);
                const unsigned p01 = cvt_pk_bf16(wv4[q4].x * r4.x, wv4[q4].y * r4.y), p23 = cvt_pk_bf16(wv4[q4].z * r4.z, wv4[q4].w * r4.w);
                *(LAS u32x2*)(WP + pr * LW + q) = (u32x2){p01, p23};
                a1 += (bf_lo(p01) * m4.x + bf_hi(p01) * m4.y) + (bf_lo(p23) * m4.z + bf_hi(p23) * m4.w); a2 += (wv4[q4].x + wv4[q4].y) + (wv4[q4].z + wv4[q4].w); }
            a1 += __shfl_xor(a1, 1); a1 += __shfl_xor(a1, 2); a2 += __shfl_xor(a2, 1); a2 += __shfl_xor(a2, 2);
            if (part == 0) { t1[pr] = a1; t2[pr] = a2; } }
        BLOCK_SYNC();
        f32x4 acc[8][2];
#pragma unroll
        for (int m = 0; m < 8; ++m) { acc[m][0] = (f32x4){0.f, 0.f, 0.f, 0.f}; acc[m][1] = (f32x4){0.f, 0.f, 0.f, 0.f}; }
#pragma unroll 1
        for (int k = 0; k < 4; ++k) {
            bf16x8 Vf[2];
#pragma unroll
            for (int n = 0; n < 2; ++n) Vf[n] = *(const LAS bf16x8*)(VT + (32 * w + 16 * n + fr) * LW + 32 * k + 8 * fq);
#pragma unroll
            for (int m = 0; m < 8; ++m) { const bf16x8 Wf = *(const LAS bf16x8*)(WP + (16 * m + fr) * LW + 32 * k + 8 * fq);
#pragma unroll
                for (int n = 0; n < 2; ++n) acc[m][n] = __builtin_amdgcn_mfma_f32_16x16x32_bf16(Vf[n], Wf, acc[m][n], 0, 0, 0); }
        }
        u32x2 ur8[8][2];
#pragma unroll
        for (int m = 0; m < 8; ++m)
#pragma unroll
            for (int n = 0; n < 2; ++n) ur8[m][n] = *(const u32x2*)(U + (size_t)(r0 + 16 * m + fr) * 2048 + g * 256 + 32 * w + 16 * n + 4 * fq);
        f32x4 vg4[2], vb4[2];
#pragma unroll
        for (int n = 0; n < 2; ++n) { const int cg_ = g * 256 + 32 * w + 16 * n + 4 * fq; vg4[n] = *(const f32x4*)(v_g + cg_); vb4[n] = *(const f32x4*)(v_b + cg_); }
#pragma unroll
        for (int m = 0; m < 8; ++m) { const int pp = 16 * m + fr; const float tt1 = t1[pp], tt2 = t2[pp], bsp = b_s[g * 128 + pp];
#pragma unroll
            for (int n = 0; n < 2; ++n) { const int cg_ = g * 256 + 32 * w + 16 * n + 4 * fq;
                u16* up = U + (size_t)(r0 + pp) * 2048 + cg_; const u32x2 ur = ur8[m][n];
                const float u0 = bf_lo(ur.x), u1 = bf_hi(ur.x), u2 = bf_lo(ur.y), u3 = bf_hi(ur.y);
                const float s0 = vg4[n].x * (acc[m][n][0] - tt1) + vb4[n].x * tt2 + bsp, s1 = vg4[n].y * (acc[m][n][1] - tt1) + vb4[n].y * tt2 + bsp;
                const float s2 = vg4[n].z * (acc[m][n][2] - tt1) + vb4[n].z * tt2 + bsp, s3 = vg4[n].w * (acc[m][n][3] - tt1) + vb4[n].w * tt2 + bsp;
                u32x2 o; o.x = cvt_pk_bf16(u0 * s0, u1 * s1); o.y = cvt_pk_bf16(u2 * s2, u3 * s3); *(u32x2*)up = o; } }
        BLOCK_SYNC();
    }
}

constexpr int CONV_NPRE = 11;
__device__ __forceinline__ void conv_lat_decode(int iu, int ntile, int j0, int& zbase_row, int& band, int& zg, int& c0) {
    const int cq = (iu >> 3) & 3, idx = (iu & 7) + 8 * (iu >> 5), tj = idx % ntile, rest = idx / ntile;
    band = rest & 7; const int b = rest >> 3; zbase_row = b * 4096 + band * 512;
    zg = tj * 4 + cq; c0 = (j0 + tj) * 128 + cq * 32;
}
__device__ __forceinline__ void conv_lat_prefetch(const u16* Z, int ld, int zbase_row, int band, int zg, const float* cw, const float* cb, int c0, int tid,
                                                  const int (&rel)[CONV_NPRE], const int (&flg)[CONV_NPRE], u32x4 (&pre)[CONV_NPRE], float (&wpre)[2]) {
    const u16* zb = Z + (((size_t)zg * MT + zbase_row) << 6);
#pragma unroll
    for (int s = 0; s < CONV_NPRE; ++s) { u32x4 v = (u32x4){0u, 0u, 0u, 0u};
        const bool ok = (flg[s] & 1) && !((flg[s] & 2) && band == 0) && !((flg[s] & 4) && band == 7);
        if (ok) v = *(const u32x4*)(zb + (ptrdiff_t)rel[s]);
        pre[s] = v; }
#pragma unroll
    for (int s = 0; s < 2; ++s) { const int i = tid + 512 * s; float v = 0.f;
        if (i < 9 * 64) { const int tap = i >> 6, ch = i & 63; v = cw[(size_t)tap * F2 + (ch < 32 ? c0 + ch : FH + c0 + ch - 32)]; }
        else if (i < 10 * 64) { const int ch = i & 63; v = cb[ch < 32 ? c0 + ch : FH + c0 + ch - 32]; }
        wpre[s] = v; }
}
__device__ __forceinline__ void phase_ffn_conv(LAS unsigned char* lds, const u16* Z, int ntile, int j0, const float* cw, const float* cb, u16* A2, bool with_ctx, unsigned long long& tpr) {
    LAS u16* T = (LAS u16*)lds;
    LAS float* Wc = (LAS float*)(lds + 100352);
    const int tid = opaque_tid();
    const int n_lat = 16 * 8 * ntile * 4, n_all = n_lat + (with_ctx ? 16 * ntile * 4 : 0);
    const int ld = ntile * 256;
    u32x4 pre[CONV_NPRE]; float wpre[2];
    {
        int rel[CONV_NPRE], loff[CONV_NPRE], flg[CONV_NPRE];
#pragma unroll
        for (int s = 0; s < CONV_NPRE; ++s) { const int pc = tid + 512 * s; const int o = pc & 7, pos = pc >> 3, lr = pos / 66, lc = pos - lr * 66;
            const bool ex = pc < 10 * 66 * 8;
            rel[s] = ((lr - 1) * 64 + (lc - 1)) * 64 + o * 8; loff[s] = (pos * 64 + (o & 3) * 16 + (o >> 2) * 8);
            flg[s] = ((ex && lc >= 1 && lc <= 64) ? 1 : 0) | (lr == 0 ? 2 : 0) | (lr == 9 ? 4 : 0) | (ex ? 8 : 0); }
        const int oct = tid & 3, col = (tid >> 2) & 63, rh = tid >> 8;
        const int tb = ((4 * rh) * 66 + col) * 64 + oct * 16;
        int it = obid(); const int G = ogdim();
        int zrow = 0, band = 0, zg = 0, c0 = 0;
        if (it < n_lat) { conv_lat_decode(it, ntile, j0, zrow, band, zg, c0); conv_lat_prefetch(Z, ld, zrow, band, zg, cw, cb, c0, tid, rel, flg, pre, wpre); }
        while (it < n_lat) {
            unsigned long long q0 = 0; if (PROBE_CLASS >= 14 && PROBE_CLASS <= 16) q0 = wall_clock64();
#pragma unroll
            for (int s = 0; s < CONV_NPRE; ++s) if (flg[s] & 8) *(LAS u32x4*)(T + loff[s]) = pre[s];
#pragma unroll
            for (int s = 0; s < 2; ++s) { const int i = tid + 512 * s; if (i < 10 * 64) Wc[i] = wpre[s]; }
            BLOCK_SYNC();
            unsigned long long q1 = 0; if (PROBE_CLASS >= 14 && PROBE_CLASS <= 16) { q1 = wall_clock64(); if (PROBE_CLASS == 14) tpr += q1 - q0; }
            const int crow = zrow, cc0 = c0;
            const int nxt = it + G;
            if (nxt < n_lat) { conv_lat_decode(nxt, ntile, j0, zrow, band, zg, c0); conv_lat_prefetch(Z, ld, zrow, band, zg, cw, cb, c0, tid, rel, flg, pre, wpre); }
            float gres[4][8];
#pragma unroll
            for (int half = 0; half < 2; ++half) {
                float acc[4][8];
#pragma unroll
                for (int t = 0; t < 4; ++t)
#pragma unroll
                    for (int e = 0; e < 8; ++e) acc[t][e] = Wc[576 + half * 32 + oct * 8 + e];
#pragma unroll 1
                for (int dj = 0; dj < 3; ++dj) {
                    float w[3][8];
#pragma unroll
                    for (int di = 0; di < 3; ++di)
#pragma unroll
                        for (int e = 0; e < 8; ++e) w[di][e] = Wc[(di * 3 + dj) * 64 + half * 32 + oct * 8 + e];
                    u32x4 raw[6];
#pragma unroll
                    for (int rr = 0; rr < 6; ++rr) raw[rr] = *(const LAS u32x4*)(T + tb + (rr * 66 + dj) * 64 + half * 8);
#pragma unroll
                    for (int rr = 0; rr < 6; ++rr) { float zf[8]; unpack8(raw[rr], zf);
#pragma unroll
                        for (int di = 0; di < 3; ++di) { const int t = rr - di; if (t >= 0 && t < 4) {
#pragma unroll
                            for (int e = 0; e < 8; ++e) acc[t][e] += w[di][e] * zf[e]; } } }
                }
                if (half == 0) {
#pragma unroll
                    for (int t = 0; t < 4; ++t)
#pragma unroll
                        for (int e = 0; e < 8; ++e) gres[t][e] = acc[t][e];
                } else {
#pragma unroll
                    for (int t = 0; t < 4; ++t) { float o8[8];
#pragma unroll
                        for (int e = 0; e < 8; ++e) o8[e] = siluf_(gres[t][e]) * acc[t][e];
                        *(u32x4*)(A2 + (size_t)(crow + (4 * rh + t) * 64 + col) * FH + cc0 + oct * 8) = pack8(o8); }
                }
            }
            unsigned long long q2 = 0; if (PROBE_CLASS >= 15 && PROBE_CLASS <= 16) { q2 = wall_clock64(); if (PROBE_CLASS == 15) tpr += q2 - q1; }
            BLOCK_SYNC();
            if (PROBE_CLASS == 16) tpr += wall_clock64() - q2;
            it = nxt;
        }
    }
    {
        const int oct = tid & 3, tk = tid >> 2, G = ogdim();
        const int n_ctx = n_all - n_lat;
        int it = obid();
        while (it < n_ctx) {
            const int cq = (it >> 3) & 3, idx = (it & 7) + 8 * (it >> 5), tj = idx % ntile, b = idx / ntile;
            const int base_row = ML + b * 256, c0 = (j0 + tj) * 128 + cq * 32;
            const u16* zb = Z + (((size_t)(tj * 4 + cq) * MT + base_row) << 6);
#pragma unroll
            for (int s = 0; s < 5; ++s) { const int pc = tid + 512 * s, o = pc & 7, lc = pc >> 3; u32x4 v = (u32x4){0u, 0u, 0u, 0u};
                if (pc < 258 * 8) { if (lc >= 1 && lc <= 256) v = *(const u32x4*)(zb + (lc - 1) * 64 + o * 8);
                    *(LAS u32x4*)(T + (lc * 64 + (o & 3) * 16 + (o >> 2) * 8)) = v; } }
#pragma unroll
            for (int s = 0; s < 2; ++s) { const int i = tid + 512 * s;
                if (i < 9 * 64) { const int tap = i >> 6, ch = i & 63; Wc[i] = cw[(size_t)tap * F2 + (ch < 32 ? c0 + ch : FH + c0 + ch - 32)]; }
                else if (i < 10 * 64) { const int ch = i & 63; Wc[i] = cb[ch < 32 ? c0 + ch : FH + c0 + ch - 32]; } }
            BLOCK_SYNC();
            float ag[2][8], au[2][8];
#pragma unroll
            for (int itr = 0; itr < 2; ++itr)
#pragma unroll
                for (int e = 0; e < 8; ++e) { ag[itr][e] = Wc[576 + oct * 8 + e]; au[itr][e] = Wc[576 + 32 + oct * 8 + e]; }
#pragma unroll
            for (int dj = 0; dj < 3; ++dj) { const int tap = 3 + dj;
                float wg[8], wu[8];
#pragma unroll
                for (int e = 0; e < 8; ++e) { wg[e] = Wc[tap * 64 + oct * 8 + e]; wu[e] = Wc[tap * 64 + 32 + oct * 8 + e]; }
#pragma unroll
                for (int itr = 0; itr < 2; ++itr) { const int col = itr * 128 + tk;
                    const LAS u16* tp = T + ((col + dj) * 64 + oct * 16);
                    float zgv[8], zuv[8]; unpack8(*(const LAS u32x4*)tp, zgv); unpack8(*(const LAS u32x4*)(tp + 8), zuv);
#pragma unroll
                    for (int e = 0; e < 8; ++e) { ag[itr][e] += wg[e] * zgv[e]; au[itr][e] += wu[e] * zuv[e]; } }
            }
#pragma unroll
            for (int itr = 0; itr < 2; ++itr) { const int col = itr * 128 + tk; float o8[8];
#pragma unroll
                for (int e = 0; e < 8; ++e) o8[e] = siluf_(ag[itr][e]) * au[itr][e];
                *(u32x4*)(A2 + (size_t)(base_row + col) * FH + c0 + oct * 8) = pack8(o8); }
            BLOCK_SYNC();
            it += G;
        }
    }
}

__device__ __forceinline__ void phase_lru_conv(const u16* XR, const float* cw  , const float* cb, u16* XCV) {
    const size_t total = (size_t)MT * 128, stride = (size_t)ogdim() * 512;
    const int tid_ = opaque_tid();
    for (size_t idx = (size_t)obid() * 512 + tid_; idx < total; idx += stride) {
        const int r = (int)(idx >> 7), oct = (int)(idx & 127), c = oct * 8;
        int t, len; if (r < ML) { t = r & 4095; len = 4096; } else { t = (r - ML) & 255; len = 256; }
        float a[8];
#pragma unroll
        for (int e = 0; e < 8; ++e) a[e] = cb[c + e];
#pragma unroll
        for (int k = 0; k < 4; ++k) { const int tt = t + k - 2; if (tt >= 0 && tt < len) { float xv[8]; unpack8(*(const u32x4*)(XR + (size_t)(r + k - 2) * 1024 + c), xv);
#pragma unroll
            for (int e = 0; e < 8; ++e) a[e] += cw[k * 1024 + c + e] * xv[e]; } }
        *(u32x4*)(XCV + (size_t)r * 1024 + c) = pack8(a);
    }
}

__device__ __forceinline__ void phase_lru_scanA(const u16* LA0, const u16* B0, const u16* LA1, const u16* B1, float* SEG) {
    const int tid = opaque_tid();
    for (int it = obid(); it < 272; it += ogdim()) {
        const int gt = it * 512 + tid, oct = gt & 127, dir = (gt >> 7) & 1, sid = gt >> 8;
        const u16* la = (dir ? LA1 : LA0) + (size_t)sid * 128 * 1024 + oct * 8; const u16* bb = (dir ? B1 : B0) + (size_t)sid * 128 * 1024 + oct * 8;
        float ps[8], e[8];
#pragma unroll
        for (int c = 0; c < 8; ++c) { ps[c] = 0.f; e[c] = 0.f; }
#pragma unroll 8
        for (int i = 0; i < 128; ++i) { const int t = dir ? 127 - i : i; float lg[8], bv[8]; unpack8(*(const u32x4*)(la + (size_t)t * 1024), lg); unpack8(*(const u32x4*)(bb + (size_t)t * 1024), bv);
#pragma unroll
            for (int c = 0; c < 8; ++c) { ps[c] += lg[c]; e[c] = __expf(lg[c]) * e[c] + bv[c]; } }
        float* so = SEG + (((size_t)dir * 544 + sid) * 1024 + oct * 8) * 2;
#pragma unroll
        for (int c = 0; c < 8; c += 2) *(f32x4*)(so + c * 2) = (f32x4){ps[c], e[c], ps[c + 1], e[c + 1]};
    }
}
__device__ __forceinline__ void lru_carry(const float* SEG, int sid, int dir, int oct, float (&st)[8]) {
    int b, pos;
    if (sid >= 512) { b = (sid - 512) >> 1; const int s = (sid - 512) & 1; pos = dir ? 1 - s : s; }
    else { b = sid >> 5; const int s = sid & 31; pos = 2 + (dir ? 31 - s : s); }
#pragma unroll
    for (int c = 0; c < 8; ++c) st[c] = 0.f;
    for (int p = 0; p < pos; ++p) {
        int ps_;
        if (p < 2) ps_ = 512 + 2 * b + (dir ? 1 - p : p); else ps_ = b * 32 + (dir ? 31 - (p - 2) : (p - 2));
        const float* so = SEG + (((size_t)dir * 544 + ps_) * 1024 + oct * 8) * 2;
#pragma unroll
        for (int c = 0; c < 8; c += 2) { const f32x4 v = *(const f32x4*)(so + c * 2); st[c] = __expf(v.x) * st[c] + v.y; st[c + 1] = __expf(v.z) * st[c + 1] + v.w; }
    }
}
__device__ __forceinline__ void phase_lru_scanC(const u16* LA0, u16* B0, const u16* LA1, const u16* B1, const float* SEG, const u16* Y, u16* G) {
    const int tid = opaque_tid();
    for (int it = obid(); it < 136; it += ogdim()) {
        const int gt = it * 512 + tid, oct = gt & 127, sid = gt >> 7; const size_t base = (size_t)sid * 128 * 1024 + oct * 8;
        float h[8];
        lru_carry(SEG, sid, 0, oct, h);
#pragma unroll 1
        for (int t0 = 0; t0 < 128; t0 += 8) { u32x4 la8[8], b8[8];
#pragma unroll
            for (int k = 0; k < 8; ++k) { const size_t o = base + (size_t)(t0 + k) * 1024; la8[k] = *(const u32x4*)(LA0 + o); b8[k] = *(const u32x4*)(B0 + o); }
#pragma unroll
            for (int k = 0; k < 8; ++k) { const size_t o = base + (size_t)(t0 + k) * 1024; float lg[8], bv[8]; unpack8(la8[k], lg); unpack8(b8[k], bv);
#pragma unroll
                for (int c = 0; c < 8; ++c) h[c] = __expf(lg[c]) * h[c] + bv[c];
                *(u32x4*)(B0 + o) = pack8(h); } }
        lru_carry(SEG, sid, 1, oct, h);
#pragma unroll 1
        for (int i0 = 0; i0 < 128; i0 += 4) { u32x4 la4[4], b4[4], hf4[4], y4[4];
#pragma unroll
            for (int k = 0; k < 4; ++k) { const size_t o = base + (size_t)(127 - i0 - k) * 1024; la4[k] = *(const u32x4*)(LA1 + o); b4[k] = *(const u32x4*)(B1 + o); hf4[k] = *(const u32x4*)(B0 + o); y4[k] = *(const u32x4*)(Y + o); }
#pragma unroll
            for (int k = 0; k < 4; ++k) { const size_t o = base + (size_t)(127 - i0 - k) * 1024; float lg[8], bv[8], hf[8], yv[8], g8[8];
                unpack8(la4[k], lg); unpack8(b4[k], bv); unpack8(hf4[k], hf); unpack8(y4[k], yv);
#pragma unroll
                for (int c = 0; c < 8; ++c) { h[c] = __expf(lg[c]) * h[c] + bv[c]; g8[c] = (hf[c] + h[c]) * yv[c]; }
                *(u32x4*)(G + o) = pack8(g8); } }
    }
}

__device__ __forceinline__ void phase_mlstm(LAS unsigned char* lds, const u16* Q, const u16* Kx, const u16* V, const float* gates, u16* HF, u16* HB) {
    constexpr int LW = 136;
    LAS u16* R1 = (LAS u16*)lds;
    LAS u16* R2 = R1 + 128 * LW;
    LAS u16* VTs = R2 + 128 * LW;
    LAS u16* CTs = VTs + 128 * LW;
    LAS float* fb = (LAS float*)(CTs + 128 * LW);
    LAS float *lfv = fb, *igv = fb + 128, *bcum = fb + 256, *mtv = fb + 384, *iwv = fb + 512, *wv = fb + 640, *nvec = fb + 768, *qn = fb + 896, *den = fb + 1024, *rs2 = fb + 1152;
    const int tid = opaque_tid(), lane = tid & 63, wid = tid >> 6, wr = wid >> 1, wc = wid & 1, fr = lane & 15, fq = lane >> 4;
    for (int item = obid(); item < 256; item += ogdim()) {
        const int half = item & 1, dir = (item >> 1) & 1, h = (item >> 2) & 3, b = item >> 4;
        u16* HO = dir ? HB : HF;
        f32x4 accC[2][4];
#pragma unroll
        for (int a = 0; a < 2; ++a)
#pragma unroll
            for (int n = 0; n < 4; ++n) accC[a][n] = (f32x4){0.f, 0.f, 0.f, 0.f};
        for (int i = tid; i < 128 * LW / 2; i += 512) ((LAS unsigned*)CTs)[i] = 0u;
        if (tid < 128) nvec[tid] = 0.f;
        float mstate = 0.f;
        BLOCK_SYNC();
        for (int step = 0; step < 34; ++step) {
            int base;
            if (step < 2) { const int cc = dir ? 1 - step : step; base = ML + b * 256 + cc * 128; }
            else { const int lc = step - 2, cc = dir ? 31 - lc : lc; base = b * 4096 + cc * 128; }
            u32x4 kreg[4];
#pragma unroll
            for (int j = 0; j < 4; ++j) { const int pc = tid + 512 * j, i = pc & 127, c8 = pc >> 7; const size_t row = (size_t)base + (dir ? 127 - i : i);
                const u32x4 q16 = *(const u32x4*)(Q + row * 512 + h * 128 + c8 * 8); *(LAS u32x4*)(R1 + i * LW + c8 * 8) = q16;
                kreg[j] = *(const u32x4*)(Kx + row * 512 + h * 128 + c8 * 8); *(LAS u32x4*)(R2 + i * LW + c8 * 8) = kreg[j];
                const u32x4 raw = *(const u32x4*)(V + row * 1024 + h * 256 + half * 128 + c8 * 8);
                LAS u16* d = VTs + (c8 * 8) * LW + i;
                d[0 * LW] = (u16)(raw.x & 0xffffu); d[1 * LW] = (u16)(raw.x >> 16); d[2 * LW] = (u16)(raw.y & 0xffffu); d[3 * LW] = (u16)(raw.y >> 16);
                d[4 * LW] = (u16)(raw.z & 0xffffu); d[5 * LW] = (u16)(raw.z >> 16); d[6 * LW] = (u16)(raw.w & 0xffffu); d[7 * LW] = (u16)(raw.w >> 16); }
            if (tid < 128) { const size_t row = (size_t)base + (dir ? 127 - tid : tid); igv[tid] = gates[row * 16 + dir * 8 + h];
                const float f = gates[row * 16 + dir * 8 + 4 + h]; lfv[tid] = fminf(f, 0.f) - log1pf(__expf(-fabsf(f))); }
            BLOCK_SYNC();
            if (tid < 64) {
                const float l0 = lfv[2 * tid], l1 = lfv[2 * tid + 1], i0 = igv[2 * tid], i1 = igv[2 * tid + 1];
                float ps = l0 + l1;
#pragma unroll
                for (int o = 1; o < 64; o <<= 1) { const float v = __shfl_up(ps, o); if (tid >= o) ps += v; }
                const float b1 = ps, b0 = ps - l1;
                const float g0 = i0 - b0, g1 = i1 - b1;
                float pmx = fmaxf(g0, g1);
#pragma unroll
                for (int o = 1; o < 64; o <<= 1) { const float v = __shfl_up(pmx, o); if (tid >= o) pmx = fmaxf(pmx, v); }
                float pprev = __shfl_up(pmx, 1); if (tid == 0) pprev = -INFINITY;
                const float pm0 = fmaxf(pprev, g0), pm1 = pmx;
                const float mt0 = b0 + fmaxf(mstate, pm0), mt1 = b1 + fmaxf(mstate, pm1);
                bcum[2 * tid] = b0; bcum[2 * tid + 1] = b1; mtv[2 * tid] = mt0; mtv[2 * tid + 1] = mt1;
                iwv[2 * tid] = __expf(b0 + mstate - mt0); iwv[2 * tid + 1] = __expf(b1 + mstate - mt1);
            } else if (tid >= 128 && tid < 256) { const int t = tid - 128; float dq = 0.f;
#pragma unroll 2
                for (int c8 = 0; c8 < 16; ++c8) { float qv[8]; unpack8(*(const LAS u32x4*)(R1 + t * LW + c8 * 8), qv);
#pragma unroll
                    for (int e = 0; e < 8; ++e) dq += qv[e] * nvec[c8 * 8 + e]; }
                qn[t] = dq; }
            BLOCK_SYNC();
            const float m_new = mtv[127], b_end = bcum[127], decay = __expf(b_end + mstate - m_new);
            if (tid < 128) wv[tid] = __expf(b_end - bcum[tid] + igv[tid] - m_new);
            f32x4 accS[2][4], accH[2][4];
#pragma unroll
            for (int a = 0; a < 2; ++a)
#pragma unroll
                for (int n = 0; n < 4; ++n) { accS[a][n] = (f32x4){0.f, 0.f, 0.f, 0.f}; accH[a][n] = (f32x4){0.f, 0.f, 0.f, 0.f}; }
#pragma unroll 1
            for (int k = 0; k < 4; ++k) {
                bf16x8 Qf[2];
#pragma unroll
                for (int a = 0; a < 2; ++a) Qf[a] = *(const LAS bf16x8*)(R1 + (32 * wr + 16 * a + fr) * LW + 32 * k + 8 * fq);
#pragma unroll
                for (int n = 0; n < 4; ++n) { const bf16x8 Kf = *(const LAS bf16x8*)(R2 + (64 * wc + 16 * n + fr) * LW + 32 * k + 8 * fq);
#pragma unroll
                    for (int a = 0; a < 2; ++a) accS[a][n] = __builtin_amdgcn_mfma_f32_16x16x32_bf16(Kf, Qf[a], accS[a][n], 0, 0, 0); }
#pragma unroll
                for (int n = 0; n < 4; ++n) { const bf16x8 Cf = *(const LAS bf16x8*)(CTs + (64 * wc + 16 * n + fr) * LW + 32 * k + 8 * fq);
#pragma unroll
                    for (int a = 0; a < 2; ++a) accH[a][n] = __builtin_amdgcn_mfma_f32_16x16x32_bf16(Cf, Qf[a], accH[a][n], 0, 0, 0); }
            }
            BLOCK_SYNC();
#pragma unroll
            for (int a = 0; a < 2; ++a) { const int t = 32 * wr + 16 * a + fr; const float bt = bcum[t], mtt = mtv[t]; float rsum = 0.f;
#pragma unroll
                for (int n = 0; n < 4; ++n) { const int s0 = 64 * wc + 16 * n + 4 * fq; float sv[4];
#pragma unroll
                    for (int j = 0; j < 4; ++j) { const int s = s0 + j; const float dwv = (s <= t) ? __expf(bt - bcum[s] + igv[s] - mtt) : 0.f; sv[j] = accS[a][n][j] * dwv; rsum += sv[j]; }
                    u32x2 o; o.x = cvt_pk_bf16(sv[0], sv[1]); o.y = cvt_pk_bf16(sv[2], sv[3]); *(LAS u32x2*)(R2 + t * LW + s0) = o; }
                rsum += __shfl_xor(rsum, 16); rsum += __shfl_xor(rsum, 32); if (fq == 0) rs2[t * 2 + wc] = rsum; }
#pragma unroll
            for (int j = 0; j < 4; ++j) { const int pc = tid + 512 * j, i = pc & 127, c8 = pc >> 7; const float wgt = wv[i]; float kv[8]; unpack8(kreg[j], kv);
                LAS u16* d = R1 + (c8 * 8) * LW + i;
#pragma unroll
                for (int e = 0; e < 8; ++e) d[e * LW] = f2bf(kv[e] * wgt); }
            BLOCK_SYNC();
            if (tid < 128) { float sn = 0.f;
#pragma unroll 2
                for (int c8 = 0; c8 < 16; ++c8) { float kv[8]; unpack8(*(const LAS u32x4*)(R1 + tid * LW + c8 * 8), kv);
#pragma unroll
                    for (int e = 0; e < 8; ++e) sn += kv[e]; }
                nvec[tid] = decay * nvec[tid] + sn;
            } else if (tid < 256) { const int t = tid - 128; den[t] = iwv[t] * qn[t] + rs2[2 * t] + rs2[2 * t + 1]; }
#pragma unroll
            for (int a = 0; a < 2; ++a) { const float iw = iwv[32 * wr + 16 * a + fr];
#pragma unroll
                for (int n = 0; n < 4; ++n) { accH[a][n] = accH[a][n] * iw; accC[a][n] = accC[a][n] * decay; } }
#pragma unroll 1
            for (int k = 0; k < 4; ++k) {
                bf16x8 Sf[2], VTf[2];
#pragma unroll
                for (int a = 0; a < 2; ++a) { Sf[a] = *(const LAS bf16x8*)(R2 + (32 * wr + 16 * a + fr) * LW + 32 * k + 8 * fq); VTf[a] = *(const LAS bf16x8*)(VTs + (32 * wr + 16 * a + fr) * LW + 32 * k + 8 * fq); }
#pragma unroll
                for (int n = 0; n < 4; ++n) { const bf16x8 Vf = *(const LAS bf16x8*)(VTs + (64 * wc + 16 * n + fr) * LW + 32 * k + 8 * fq);
                    const bf16x8 KTf = *(const LAS bf16x8*)(R1 + (64 * wc + 16 * n + fr) * LW + 32 * k + 8 * fq);
#pragma unroll
                    for (int a = 0; a < 2; ++a) { accH[a][n] = __builtin_amdgcn_mfma_f32_16x16x32_bf16(Vf, Sf[a], accH[a][n], 0, 0, 0);
                        accC[a][n] = __builtin_amdgcn_mfma_f32_16x16x32_bf16(KTf, VTf[a], accC[a][n], 0, 0, 0); } }
            }
            BLOCK_SYNC();
#pragma unroll
            for (int a = 0; a < 2; ++a) { const int t = 32 * wr + 16 * a + fr; const float dn = fmaxf(fabsf(den[t]), __expf(-mtv[t])); const float inv = __builtin_amdgcn_rcpf(dn);
                const size_t row = (size_t)base + (dir ? 127 - t : t);
#pragma unroll
                for (int n = 0; n < 4; ++n) { const int e0 = 64 * wc + 16 * n + 4 * fq;
                    u32x2 o; o.x = cvt_pk_bf16(accH[a][n][0] * inv, accH[a][n][1] * inv); o.y = cvt_pk_bf16(accH[a][n][2] * inv, accH[a][n][3] * inv);
                    *(u32x2*)(HO + row * 1024 + h * 256 + half * 128 + e0) = o;
                    u32x2 cpk; cpk.x = cvt_pk_bf16(accC[a][n][0], accC[a][n][1]); cpk.y = cvt_pk_bf16(accC[a][n][2], accC[a][n][3]);
                    *(LAS u32x2*)(CTs + (32 * wr + 16 * a + fr) * LW + e0) = cpk; } }
            mstate = m_new;
            BLOCK_SYNC();
        }
    }
}
__device__ __forceinline__ void phase_ml_readout(const u16* HF, const u16* HB, const u16* O, const float* ng, u16* G) {
    const int tid_ = opaque_tid(); const int lane = tid_ & 63, gw = obid() * 8 + (tid_ >> 6), ngw = ogdim() * 8;
    for (int r = gw; r < MT; r += ngw) { const size_t off = (size_t)r * 1024 + lane * 16;
        float hs[16], a[8], bq[8];
        unpack8(*(const u32x4*)(HF + off), a); unpack8(*(const u32x4*)(HB + off), bq);
#pragma unroll
        for (int e = 0; e < 8; ++e) hs[e] = a[e] + bq[e];
        unpack8(*(const u32x4*)(HF + off + 8), a); unpack8(*(const u32x4*)(HB + off + 8), bq);
#pragma unroll
        for (int e = 0; e < 8; ++e) hs[8 + e] = a[e] + bq[e];
        float ss = 0.f;
#pragma unroll
        for (int e = 0; e < 16; ++e) ss += hs[e] * hs[e];
        ss += __shfl_xor(ss, 1); ss += __shfl_xor(ss, 2); ss += __shfl_xor(ss, 4); ss += __shfl_xor(ss, 8);
        const float rstd = __builtin_amdgcn_rsqf(ss * (1.0f / 256.0f) + 1e-6f);
        float o0[8], o1[8], g0[8], g1[8];
        unpack8(*(const u32x4*)(O + off), o0); unpack8(*(const u32x4*)(O + off + 8), o1);
#pragma unroll
        for (int e = 0; e < 8; ++e) { g0[e] = o0[e] * hs[e] * rstd * ng[lane * 16 + e]; g1[e] = o1[e] * hs[8 + e] * rstd * ng[lane * 16 + 8 + e]; }
        *(u32x4*)(G + off) = pack8(g0); *(u32x4*)(G + off + 8) = pack8(g1);
    }
}


#define XB_TMO      128
#define XB_XCNT(j)  (256  + 64 * (j))
#define XB_XSUB(j)  (1280 + 64 * (j))
#define XB_XGEN(j)  (2304 + 64 * (j))
#define XB_TOP      3328
#define XB_TOPGEN   3392
#define XCD_BAR_WORDS 3456
#define XB_SPIN_CAP (1u << 22)
__device__ __forceinline__ unsigned xb_ld(unsigned* p)              { return __hip_atomic_load(p, __ATOMIC_RELAXED, __HIP_MEMORY_SCOPE_AGENT); }
__device__ __forceinline__ unsigned xb_add(unsigned* p, unsigned v) { return __hip_atomic_fetch_add(p, v, __ATOMIC_RELAXED, __HIP_MEMORY_SCOPE_AGENT); }
__device__ __forceinline__ unsigned xb_xcc_id() { return (unsigned)__builtin_amdgcn_s_getreg((3 << 11) | 20) & 0xFu; }
#define XB_SPIN(cond, bar) do { unsigned _sp = 0; while (cond) { __builtin_amdgcn_s_sleep(1); \
    if ((++_sp & 255u) == 0u) { if (xb_ld(&(bar)[XB_TMO])) break; if (_sp > XB_SPIN_CAP) { atomicAdd(&(bar)[XB_TMO], 1u); break; } } } } while (0)
__device__ __forceinline__ void xcd_barrier_complete(unsigned* bar, unsigned x, unsigned& nloc, unsigned& nx) {
    const unsigned G = gridDim.x * gridDim.y * gridDim.z;
    unsigned sum, cnt, mine, sp = 0u;
    for (;;) {
        sum = 0u; cnt = 0u; mine = 0u;
#pragma unroll
        for (unsigned j = 0; j < 16; ++j) { const unsigned c = xb_ld(&bar[XB_XCNT(j)]); sum += c; cnt += (c > 0u) ? 1u : 0u; mine = (j == x) ? c : mine; }
        if (sum == G) break;
        __builtin_amdgcn_s_sleep(1);
        if ((++sp & 255u) == 0u) { if (xb_ld(&bar[XB_TMO])) break; if (sp > XB_SPIN_CAP) { atomicAdd(&bar[XB_TMO], 1u); break; } }
    }
    nloc = mine > 0u ? mine : 1u; nx = cnt > 0u ? cnt : 1u;
}
__device__ __forceinline__ void xcd_barrier(unsigned* bar, volatile LAS unsigned* st) {
    asm volatile("s_waitcnt vmcnt(0)" ::: "memory");
    __syncthreads();
    if (threadIdx.x == 0) {
        const unsigned x = xb_xcc_id();
        __builtin_amdgcn_s_waitcnt(0);
        unsigned nloc = st[0], nx = st[1];
        if (nloc == 0u) { xcd_barrier_complete(bar, x, nloc, nx); st[0] = nloc; st[1] = nx; }
        const unsigned old = xb_add(&bar[XB_XSUB(x)], 1u);
        const unsigned gen = old / nloc;
        if (old + 1u == (gen + 1u) * nloc) {
            __builtin_amdgcn_fence(__ATOMIC_RELEASE, "agent");
            asm volatile("s_waitcnt vmcnt(0)" ::: "memory");
            const unsigned og = xb_add(&bar[XB_TOP], 1u);
            const unsigned tg = og / nx;
            if (og + 1u == (tg + 1u) * nx) xb_add(&bar[XB_TOPGEN], 1u);
            else XB_SPIN(xb_ld(&bar[XB_TOPGEN]) == tg, bar);
            __builtin_amdgcn_fence(__ATOMIC_ACQUIRE, "agent");
            xb_add(&bar[XB_XGEN(x)], 1u);
            asm volatile("s_waitcnt vmcnt(0)" ::: "memory");
        } else {
            XB_SPIN(xb_ld(&bar[XB_XGEN(x)]) == gen, bar);
            __builtin_amdgcn_fence(__ATOMIC_ACQUIRE, "agent");
            asm volatile("s_waitcnt vmcnt(0)" ::: "memory");
        }
    }
    __syncthreads();
}

constexpr int PTAB_OFF = LDS_BYTES - 512;
#define SYNC0(c) do { grid.sync(); if (PROBE_CLASS) { const unsigned long long _n = wall_clock64(); if (PROBE_CLASS == (c)) tacc += _n - pt0; pt0 = _n; if (PROBE_CLASS == 10) { cyc0 = clock64(); } } } while (0)
#define SYNC(c) do { xcd_barrier((unsigned*)WSP(WS_BAR), (volatile LAS unsigned*)(lds + PTAB_OFF + 384)); if (PROBE_CLASS) { const unsigned long long _n = wall_clock64(); if (PROBE_CLASS == (c)) tacc += _n - pt0; pt0 = _n; if (PROBE_CLASS == 10) { const unsigned long long _c = clock64(); if ((c) == 1) cycacc += _c - cyc0; cyc0 = _c; } } } while (0)
enum { I_X = 0, I_C, I_CTX, I_CCTX, I_N1G, I_N2G, I_MODW, I_MODB, I_FUP, I_FCW, I_FCB, I_FDN, I_CMIN, I_CMBIN, I_CMVG, I_CMVB, I_CMWS, I_CMBS, I_CMOUT,
       I_LIN, I_LCW, I_LCB, I_LWRG, I_LBRG, I_LWIG, I_LBIG, I_LLAM, I_LOUT, I_MIN, I_MBG, I_MNG, I_MOUT, I_FNG, I_OUT, I_WS };
__device__ __forceinline__ unsigned char* getp(LAS unsigned char* lds, int idx) {
    unsigned a = PTAB_OFF; asm volatile("" : "+v"(a));
    volatile LAS unsigned* t = (volatile LAS unsigned*)(lds + a);
    unsigned lo = t[2 * idx], hi = t[2 * idx + 1];
    lo = __builtin_amdgcn_readfirstlane(lo); hi = __builtin_amdgcn_readfirstlane(hi);
    return (unsigned char*)(((unsigned long long)hi << 32) | (unsigned long long)lo);
}
#define GF(i) ((const float*)getp(lds, (i)))
#define WSP(off) (getp(lds, I_WS) + (off))

__global__ void __launch_bounds__(512, 2) mega_fwd(Params P) {
    extern __shared__ __attribute__((aligned(16))) unsigned char shm[];
    LAS unsigned char* lds = (LAS unsigned char*)shm;
    cg::grid_group grid = cg::this_grid();
    if (threadIdx.x < 35) { const unsigned long long v = ((const unsigned long long*)&P)[threadIdx.x]; LAS unsigned* t = (LAS unsigned*)(lds + PTAB_OFF); t[2 * threadIdx.x] = (unsigned)v; t[2 * threadIdx.x + 1] = (unsigned)(v >> 32); }
    if (threadIdx.x == 0) { LAS unsigned* stw = (LAS unsigned*)(lds + PTAB_OFF + 384); stw[0] = 0u; stw[1] = 0u; stw[2] = 0u; stw[3] = 0u; }
    BLOCK_SYNC();
    if (threadIdx.x == 0) (void)xb_add(&((unsigned*)P.ws + WS_BAR / 4)[XB_XCNT(xb_xcc_id())], 1u);
    unsigned long long tacc = 0, pt0 = PROBE_CLASS ? wall_clock64() : 0ull, nkt = 0, cyc0 = 0, cycacc = 0;
    phase_prologue(lds, P);
    SYNC0(7);
    {
        float* SHW = (float*)WSP(WS_SHW); const float* MOD = (const float*)WSP(WS_MOD);
        shw_table(lds, MOD + (size_t)0 * 17 * 6144, 0, (const u16*)WSP(WS_CM_IN_T), 4096, SHW + SHW_IN_OFF0);
        shw_table(lds, MOD + (size_t)1 * 17 * 6144, 0, (const u16*)WSP(WS_LRU_IN_T), 2048, SHW + SHW_IN_OFF1);
        shw_table(lds, MOD + (size_t)2 * 17 * 6144, 0, (const u16*)WSP(WS_ML_IN_T), 3328, SHW + SHW_IN_OFF2);
        shw_table(lds, MOD + (size_t)3 * 17 * 6144, 0, (const u16*)WSP(WS_CM_IN_T) + (size_t)4096 * 1024, 4096, SHW + SHW_IN_OFF3);
#pragma unroll 1
        for (int l = 0; l < 4; ++l) shw_table(lds, MOD + (size_t)l * 17 * 6144, 3072, (const u16*)WSP(WS_FFN_UP_T + l * SZ_FFN_UP_T), F2, SHW + SHW_UP_OFF + (size_t)l * 17 * F2);
        phase_pre0(GF(I_X), GF(I_CTX), GF(I_N1G), MOD, 1024, (u16*)WSP(WS_ACT), (float*)WSP(WS_RS), MT);
    }
    SYNC(3);

#pragma unroll 1
    for (int l = 0; l < 4; ++l) {
        const int kind = l % 3, j = l / 3; const bool last = (l == 3);
        const int nM = last ? 256 : 272, nrows = last ? ML : MT;
        g8::Desc dout{};
        if (kind == 0) {
            { g8::Desc d{}; d.A = (const u16*)WSP(WS_ACT); d.Bt = (const u16*)WSP(WS_CM_IN_T) + (size_t)j * 4096 * 1024; d.lda = 1024; d.ldb = 1024; d.K = 1024; d.nM = nM; d.nN = 16; d.nZ = 1; d.ablk = 1;
              Epi<M_CMIN> E{}; E.p.o0 = (u16*)WSP(WS_ACT + SLOT); E.p.o1 = (u16*)WSP(WS_ACT + 3 * SLOT); E.p.f0 = (float*)WSP(WS_ACT + 6 * SLOT); E.p.bias = GF(I_CMBIN) + j * 4096; E.p.rsr = (const float*)WSP(WS_RS); E.p.shw = (const float*)WSP(WS_SHW) + (l == 0 ? SHW_IN_OFF0 : SHW_IN_OFF3); E.p.shwld = 4096;
              g8::gemm_phase(lds, d, E, tacc, nkt); }
            SYNC(1);
            phase_cm_spatial(lds, (u16*)WSP(WS_ACT + SLOT), (const u16*)WSP(WS_ACT + 3 * SLOT), (const float*)WSP(WS_ACT + 6 * SLOT), GF(I_CMWS) + (size_t)j * 8 * 128 * 128, GF(I_CMBS) + j * 8 * 128,
                             GF(I_CMVG) + j * 2048, GF(I_CMVB) + j * 2048, nrows / 128);
            SYNC(4);
            dout.A = (const u16*)WSP(WS_ACT + SLOT); dout.Bt = (const u16*)WSP(WS_CM_OUT_T) + (size_t)j * 1024 * 2048; dout.lda = 2048; dout.ldb = 2048; dout.K = 2048;
        } else if (kind == 1) {
            { g8::Desc d{}; d.A = (const u16*)WSP(WS_ACT); d.Bt = (const u16*)WSP(WS_LRU_IN_T); d.lda = 1024; d.ldb = 1024; d.K = 1024; d.nM = nM; d.nN = 8; d.nZ = 1; d.ablk = 1;
              Epi<M_LRUIN> E{}; E.p.o0 = (u16*)WSP(WS_ACT + SLOT); E.p.o1 = (u16*)WSP(WS_ACT + 2 * SLOT); E.p.rsr = (const float*)WSP(WS_RS); E.p.shw = (const float*)WSP(WS_SHW) + SHW_IN_OFF1; E.p.shwld = 2048;
              g8::gemm_phase(lds, d, E, tacc, nkt); }
            SYNC(1);
            phase_lru_conv((const u16*)WSP(WS_ACT + 2 * SLOT), GF(I_LCW), GF(I_LCB), (u16*)WSP(WS_ACT + 3 * SLOT));
            SYNC(3);
            { g8::Desc d{}; d.A = (const u16*)WSP(WS_ACT + 3 * SLOT); d.Bt = (const u16*)WSP(WS_LRU_G_T); d.lda = 1024; d.ldb = 256; d.K = 256; d.nM = nM; d.nN = 4; d.nZ = 4; d.zA = 256; d.zB = (size_t)1024 * 256;
              Epi<M_LRUG> E{}; E.p.o0 = (u16*)WSP(WS_ACT); E.p.o1 = (u16*)WSP(WS_ACT + 2 * SLOT);
              E.p.q0 = GF(I_LBRG); E.p.q1 = GF(I_LBIG); E.p.q2 = (const float*)WSP(WS_SP8); E.p.bsrc = (const u16*)WSP(WS_ACT + 3 * SLOT);
              g8::gemm_phase(lds, d, E, tacc, nkt); }
            SYNC(1);
            phase_lru_scanA((const u16*)WSP(WS_ACT), (const u16*)WSP(WS_ACT + 2 * SLOT), (const u16*)WSP(WS_ACT + 4 * SLOT), (const u16*)WSP(WS_ACT + 5 * SLOT), (float*)WSP(WS_SEG));
            SYNC(6);
            phase_lru_scanC((const u16*)WSP(WS_ACT), (u16*)WSP(WS_ACT + 2 * SLOT), (const u16*)WSP(WS_ACT + 4 * SLOT), (const u16*)WSP(WS_ACT + 5 * SLOT), (const float*)WSP(WS_SEG),
                            (const u16*)WSP(WS_ACT + SLOT), (u16*)WSP(WS_ACT + 3 * SLOT));
            SYNC(6);
            dout.A = (const u16*)WSP(WS_ACT + 3 * SLOT); dout.Bt = (const u16*)WSP(WS_LRU_OUT_T); dout.lda = 1024; dout.ldb = 1024; dout.K = 1024;
        } else {
            { g8::Desc d{}; d.A = (const u16*)WSP(WS_ACT); d.Bt = (const u16*)WSP(WS_ML_IN_T); d.lda = 1024; d.ldb = 1024; d.K = 1024; d.nM = nM; d.nN = 13; d.nZ = 1; d.ablk = 1;
              Epi<M_MLIN> E{}; E.p.o0 = (u16*)WSP(WS_ACT + SLOT); E.p.o1 = (u16*)WSP(WS_ACT + SLOT) + (size_t)MT * 512; E.p.o2 = (u16*)WSP(WS_ACT + 2 * SLOT); E.p.o3 = (u16*)WSP(WS_ACT + 3 * SLOT);
              E.p.f0 = (float*)WSP(WS_ACT + 6 * SLOT); E.p.bias = GF(I_MBG); E.p.rsr = (const float*)WSP(WS_RS); E.p.shw = (const float*)WSP(WS_SHW) + SHW_IN_OFF2; E.p.shwld = 3328;
              g8::gemm_phase(lds, d, E, tacc, nkt); }
            SYNC(1);
            phase_mlstm(lds, (const u16*)WSP(WS_ACT + SLOT), (const u16*)WSP(WS_ACT + SLOT) + (size_t)MT * 512, (const u16*)WSP(WS_ACT + 2 * SLOT), (const float*)WSP(WS_ACT + 6 * SLOT),
                        (u16*)WSP(WS_ACT + 4 * SLOT), (u16*)WSP(WS_ACT + 5 * SLOT));
            SYNC(5);
            phase_ml_readout((const u16*)WSP(WS_ACT + 4 * SLOT), (const u16*)WSP(WS_ACT + 5 * SLOT), (const u16*)WSP(WS_ACT + 3 * SLOT), GF(I_MNG), (u16*)WSP(WS_ACT + 3 * SLOT));
            SYNC(3);
            dout.A = (const u16*)WSP(WS_ACT + 3 * SLOT); dout.Bt = (const u16*)WSP(WS_ML_OUT_T); dout.lda = 1024; dout.ldb = 1024; dout.K = 1024;
        }
        { dout.nM = nM; dout.nN = 4; dout.nZ = 1;
          Epi<M_RES> E{}; E.p.xsl = (l == 0) ? GF(I_X) : GF(I_OUT); E.p.xsc = (l == 0) ? GF(I_CTX) : (const float*)WSP(WS_XC); E.p.xdl = (float*)getp(lds, I_OUT); E.p.xdc = (float*)WSP(WS_XC);
          E.p.gate = (const float*)WSP(WS_MOD) + (size_t)l * 17 * 6144 + 2048;
          E.p.ng = GF(I_N2G) + l * 1024; E.p.nsc = (const float*)WSP(WS_MOD) + (size_t)l * 17 * 6144 + 4096; E.p.xb = (u16*)WSP(WS_ACT); E.p.rs = (float*)WSP(WS_RS);
          g8::gemm_phase(lds, dout, E, tacc, nkt); }
        SYNC(1);
#pragma unroll 1
        for (int part = 0; part < 2; ++part) {
            const int pn0 = part ? 11 : 0, nt = part ? 10 : 11;
            { g8::Desc d{}; d.A = (const u16*)WSP(WS_ACT); d.Bt = (const u16*)WSP(WS_FFN_UP_T + l * SZ_FFN_UP_T); d.lda = 1024; d.ldb = 1024; d.K = 1024; d.nM = nM; d.nN = nt; d.nZ = 1; d.pn0 = pn0; d.ablk = 1;
              Epi<M_BF16> E{}; E.p.o0 = (u16*)WSP(WS_ACT + SLOT); E.p.ldc = nt * 256; E.p.pn0 = pn0; E.p.rsr = (const float*)WSP(WS_RS); E.p.shw = (const float*)WSP(WS_SHW) + SHW_UP_OFF + (size_t)l * 17 * F2; E.p.shwld = F2;
              g8::gemm_phase(lds, d, E, tacc, nkt); }
            SYNC(1);
            phase_ffn_conv(lds, (const u16*)WSP(WS_ACT + SLOT), nt, pn0, GF(I_FCW) + (size_t)l * 9 * F2, GF(I_FCB) + (size_t)l * F2, (u16*)WSP(WS_ACT + SLOT + (size_t)MT * 2816 * 2), !last, tacc);
            SYNC(2);
        }
        { g8::Desc d{}; d.A = (const u16*)WSP(WS_ACT + SLOT + (size_t)MT * 2816 * 2); d.Bt = (const u16*)WSP(WS_FFN_DN_T + l * SZ_FFN_DN_T); d.lda = FH; d.ldb = FH; d.K = FH; d.nM = nM; d.nN = 4; d.nZ = 1;
          Epi<M_RES> E{}; E.p.xsl = GF(I_OUT); E.p.xsc = (const float*)WSP(WS_XC); E.p.xdl = (float*)getp(lds, I_OUT); E.p.xdc = (float*)WSP(WS_XC);
          E.p.gate = (const float*)WSP(WS_MOD) + (size_t)l * 17 * 6144 + 5120;
          if (!last) { E.p.ng = GF(I_N1G) + (l + 1) * 1024; E.p.nsc = (const float*)WSP(WS_MOD) + (size_t)(l + 1) * 17 * 6144 + 1024; E.p.xb = (u16*)WSP(WS_ACT); E.p.rs = (float*)WSP(WS_RS); }
          g8::gemm_phase(lds, d, E, tacc, nkt); }
        SYNC(1);
    }
    phase_final_norm((float*)getp(lds, I_OUT), GF(I_FNG));
    if (PROBE_CLASS == 17) { for (int i = 0; i < 100; ++i) grid.sync(); tacc = 0; }
    if (PROBE_CLASS == 9 || PROBE_CLASS == 11 || PROBE_CLASS == 12) tacc = nkt ? (tacc * 100ull) / nkt : 0ull;
    if (PROBE_CLASS == 10) tacc = cycacc / 20ull;
    if (PROBE_CLASS) { const unsigned long long tend = wall_clock64() + tacc; while (wall_clock64() < tend) __builtin_amdgcn_s_sleep(16); }
}

extern "C" void kernel_launch(void* const* d_in, const int* in_sizes, int n_in, void* d_out, int out_size, void* d_ws, size_t ws_size, hipStream_t stream) {
    static int grid = 0;
    if (grid == 0) {
        if (n_in != 33 || ws_size < WS_END) { fprintf(stderr, "kernel_launch: unexpected n_in %d or ws_size %zu (< %zu)\n", n_in, ws_size, (size_t)WS_END); grid = -1; return; }
        int dev = 0, cus = 0, per_cu = 0;
        hipGetDevice(&dev); hipDeviceGetAttribute(&cus, hipDeviceAttributeMultiprocessorCount, dev);
        if (hipFuncSetAttribute((const void*)mega_fwd, hipFuncAttributeMaxDynamicSharedMemorySize, LDS_BYTES) != hipSuccess) { fprintf(stderr, "kernel_launch: hipFuncSetAttribute failed\n"); grid = -1; return; }
        hipOccupancyMaxActiveBlocksPerMultiprocessor(&per_cu, (const void*)mega_fwd, 512, LDS_BYTES);
        (void)hipGetLastError();
        if (per_cu < 1) per_cu = 1;
        grid = cus * 1;
    }
    if (grid < 0) return;
    Params p{};
    const float** pp = (const float**)&p;
    for (int i = 0; i < 33; ++i) pp[i] = (const float*)d_in[i];
    p.out = (float*)d_out; p.ws = (unsigned char*)d_ws;
    (void)hipMemsetAsync((unsigned char*)d_ws + WS_BAR, 0, 16384, stream);
    void* args[] = {&p};
    hipError_t e = hipLaunchCooperativeKernel((const void*)mega_fwd, dim3(grid), dim3(512), args, LDS_BYTES, stream);
    if (e != hipSuccess) fprintf(stderr, "cooperative launch failed: %s (grid %d)\n", hipGetErrorString(e), grid);
}
```

```cpp
#include <hip/hip_runtime.h>
#include <hip/hip_cooperative_groups.h>
#include <cstdio>
namespace cg = cooperative_groups;

#define LAS __attribute__((address_space(3)))
typedef unsigned short u16;
typedef short bf16x8 __attribute__((ext_vector_type(8)));
typedef float f32x4 __attribute__((ext_vector_type(4)));
typedef float f32x2 __attribute__((ext_vector_type(2)));
typedef unsigned u32x4 __attribute__((ext_vector_type(4)));
typedef unsigned u32x2 __attribute__((ext_vector_type(2)));

constexpr int DM = 1024, NB = 16, SEQ = 4096, CTXL = 256;
constexpr int ML = NB * SEQ, MC = NB * CTXL, MT = ML + MC;
constexpr int FH = 2688, F2 = 5376;
constexpr int LDS_BYTES = 147456;
#ifndef PROBE_CLASS
#define PROBE_CLASS 0
#endif
#define XCD_REMAP 1

constexpr size_t SZ_FFN_UP_T = (size_t)F2 * 1024 * 2, SZ_FFN_DN_T = (size_t)1024 * FH * 2;
constexpr size_t WS_FFN_UP_T = 0;
constexpr size_t WS_FFN_DN_T = WS_FFN_UP_T + 4 * SZ_FFN_UP_T;
constexpr size_t WS_CM_IN_T = WS_FFN_DN_T + 4 * SZ_FFN_DN_T;
constexpr size_t WS_CM_OUT_T = WS_CM_IN_T + 2 * (size_t)4096 * 1024 * 2;
constexpr size_t WS_LRU_IN_T = WS_CM_OUT_T + 2 * (size_t)1024 * 2048 * 2;
constexpr size_t WS_LRU_G_T = WS_LRU_IN_T + (size_t)2048 * 1024 * 2;
constexpr size_t WS_LRU_OUT_T = WS_LRU_G_T + (size_t)4 * 1024 * 256 * 2;
constexpr size_t WS_ML_IN_T = WS_LRU_OUT_T + (size_t)1024 * 1024 * 2;
constexpr size_t WS_ML_OUT_T = WS_ML_IN_T + (size_t)3328 * 1024 * 2;
constexpr size_t WS_XC = WS_ML_OUT_T + (size_t)1024 * 1024 * 2;
constexpr size_t WS_MOD = WS_XC + (size_t)MC * 1024 * 4;
constexpr size_t WS_SEG = WS_MOD + (size_t)4 * 17 * 6144 * 4;
constexpr size_t WS_SP8 = WS_SEG + (size_t)2 * 544 * 1024 * 2 * 4;
constexpr size_t WS_RS = WS_SP8 + 8192;
constexpr size_t WS_SHW = WS_RS + (size_t)MT * 16 * 4;
constexpr int SHW_IN_OFF0 = 0, SHW_IN_OFF1 = 17 * 4096, SHW_IN_OFF2 = SHW_IN_OFF1 + 17 * 2048, SHW_IN_OFF3 = SHW_IN_OFF2 + 17 * 3328, SHW_UP_OFF = SHW_IN_OFF3 + 17 * 4096;
constexpr size_t WS_BAR = WS_SHW + (size_t)(SHW_UP_OFF + 4 * 17 * F2) * 4;
constexpr size_t WS_ACT = WS_BAR + 16384;
constexpr size_t SLOT = (size_t)MT * 1024 * 2;
constexpr size_t WS_END = WS_ACT + SLOT + (size_t)MT * 2816 * 2 + (size_t)MT * FH * 2;

struct Params {
    const float *x, *c, *ctx, *c_ctx, *norm1_g, *norm2_g, *mod_w, *mod_b, *ffn_w_up, *ffn_conv_w, *ffn_conv_b, *ffn_w_down,
        *cm_w_in, *cm_b_in, *cm_v_g, *cm_v_b, *cm_w_s, *cm_b_s, *cm_w_out, *lru_w_in, *lru_conv_w, *lru_conv_b, *lru_w_rg, *lru_b_rg,
        *lru_w_ig, *lru_b_ig, *lru_lambda, *lru_w_out, *ml_w_in, *ml_b_gate, *ml_norm_g, *ml_w_out, *final_norm_g;
    float* out; unsigned char* ws;
};

__device__ __forceinline__ unsigned cvt_pk_bf16(float lo, float hi) { unsigned r; asm volatile("v_cvt_pk_bf16_f32 %0, %1, %2" : "=v"(r) : "v"(lo), "v"(hi)); return r; }
__device__ __forceinline__ float bf_lo(unsigned w) { return __uint_as_float(w << 16); }
__device__ __forceinline__ float bf_hi(unsigned w) { return __uint_as_float(w & 0xffff0000u); }
__device__ __forceinline__ float bf2f(u16 b) { return __uint_as_float(((unsigned)b) << 16); }
__device__ __forceinline__ u16 f2bf(float f) { return (u16)(cvt_pk_bf16(f, 0.f) & 0xffffu); }
__device__ __forceinline__ float wave_sum(float v) {
#pragma unroll
    for (int o = 1; o < 64; o <<= 1) v += __shfl_xor(v, o);
    return v;
}
__device__ __forceinline__ float fexp_(float x) { return __builtin_amdgcn_exp2f(x * 1.4426950408889634f); }
__device__ __forceinline__ float sigmoidf_(float x) { return __builtin_amdgcn_rcpf(1.0f + fexp_(-x)); }
__device__ __forceinline__ float gelu_tanh(float x) { const float t = x * (1.5957691216f + 0.0713548163f * x * x); return x * __builtin_amdgcn_rcpf(1.0f + fexp_(-t)); }
__device__ __forceinline__ float siluf_(float x) { return x * __builtin_amdgcn_rcpf(1.0f + fexp_(-x)); }
__device__ __forceinline__ void unpack8(const u32x4 w, float (&f)[8]) {
    f[0] = bf_lo(w.x); f[1] = bf_hi(w.x); f[2] = bf_lo(w.y); f[3] = bf_hi(w.y); f[4] = bf_lo(w.z); f[5] = bf_hi(w.z); f[6] = bf_lo(w.w); f[7] = bf_hi(w.w);
}
__device__ __forceinline__ u32x4 pack8(const float (&f)[8]) {
    u32x4 w; w.x = cvt_pk_bf16(f[0], f[1]); w.y = cvt_pk_bf16(f[2], f[3]); w.z = cvt_pk_bf16(f[4], f[5]); w.w = cvt_pk_bf16(f[6], f[7]); return w;
}
#define BLOCK_SYNC() __syncthreads()
__device__ __forceinline__ size_t ablk(int row, int col, int KT) { return ((((size_t)(row >> 8) * KT + (col >> 6)) * 256 + (row & 255)) << 6) + (col & 63); }
__device__ __forceinline__ int obid() { int t = blockIdx.x; asm volatile("" : "+s"(t)); return t; }
__device__ __forceinline__ int ogdim() { int t = gridDim.x; asm volatile("" : "+s"(t)); return t; }
__device__ __forceinline__ int opaque_tid() { int t = threadIdx.x; asm volatile("" : "+v"(t)); return t; }

namespace g8 {
constexpr int BM = 256, BK = 64, HALF = 128, HTB = HALF * BK * 2, STAGE_BYTES = 8 * HTB, NXCD = 8, WGM = 4;
__device__ __forceinline__ int lds_byte(int r, int c) { const int st = (r >> 4) * 2 + (c >> 5), rr = r & 15, cc = c & 31, ob = rr * 64 + cc * 2; return st * 1024 + (ob ^ (((ob >> 9) & 1) << 5)); }
__device__ __forceinline__ void stage_rc(int b, int& R, int& C) { const int st = b / 1024, sb = b % 1024, swz = sb ^ (((sb >> 9) & 1) << 5); R = (st >> 1) * 16 + swz / 64; C = (st & 1) * 32 + (swz % 64) / 2; }
__device__ __forceinline__ int perm32(int rho) { const int n = rho >> 4, i = rho & 15; return 8 * (i >> 2) + 4 * n + (i & 3); }

struct Unit { int pm, pn, z; };
struct Desc { const u16* A; const u16* Bt; int lda, ldb, K, nM, nN, nZ, pm0, pn0; size_t zA, zB; int ablk; };

__device__ __forceinline__ bool next_unit(const Desc& g, int i, Unit& u) {
    const int nwg = g.nM * g.nN; const long L = (long)i * ogdim() + obid(); if (L >= (long)nwg * g.nZ) return false;
    u.z = (int)(L / nwg); int wgid = (int)(L % nwg);
#if XCD_REMAP
    { const int q = nwg / NXCD, r = nwg % NXCD, xcd = wgid % NXCD, off = wgid / NXCD; wgid = (xcd < r ? xcd * (q + 1) : r * (q + 1) + (xcd - r) * q) + off; }
#endif
    const int nig = WGM * g.nN, gid = wgid / nig, fm = gid * WGM, gsz = (g.nM - fm) < WGM ? (g.nM - fm) : WGM;
    u.pm = g.pm0 + fm + ((wgid % nig) % gsz); u.pn = g.pn0 + (wgid % nig) / gsz; return true;
}

template <class Epi>
__device__ __forceinline__ void gemm_phase(LAS unsigned char* lds, const Desc g, const Epi& E, unsigned long long& tepi, unsigned long long& g_ktiles) {
    const int tid = opaque_tid(), wid = __builtin_amdgcn_readfirstlane(tid >> 6), lane = tid & 63, wr = wid >> 2, wc = wid & 3, fr = lane & 15, fq = lane >> 4;
    const int K = g.K, nt = K / BK;
    unsigned voffA[2], voffB[2];
#pragma unroll
    for (int i = 0; i < 2; ++i) { int R, C; stage_rc(tid * 16 + i * 8192, R, C); const int Rb = Epi::PERM ? ((R & ~31) + perm32(R & 31)) : R;
        voffA[i] = g.ablk ? (unsigned)(R * 64 + C) * 2u : (unsigned)(R * g.lda + C) * 2u; voffB[i] = (unsigned)(Rb * g.ldb + C) * 2u; }
    const size_t kstepB = (size_t)(BK * 2), kstepA = g.ablk ? (size_t)(256 * BK * 2) : (size_t)(BK * 2);
    const size_t hstepA = g.ablk ? (size_t)(HALF * BK * 2) : (size_t)HALF * g.lda * 2, hstepB = (size_t)HALF * g.ldb * 2;
    const size_t tstepA = (size_t)256 * g.lda * 2, tstepB = 2 * hstepB;
    const unsigned ldsw = (unsigned)wid * 1024u;
    const int aoff = lds_byte(wr * 64 + fr, fq * 8), boff = lds_byte(wc * 32 + fr, fq * 8);
#define PG8_SA(b, h) (((b) * 2 + (h)) * HTB)
#define PG8_SB(b, h) ((4 + (b) * 2 + (h)) * HTB)
#define PG8_STAGE(bufoff, gbase, voff) do { _Pragma("unroll") for (int _i = 0; _i < 2; ++_i) \
        __builtin_amdgcn_global_load_lds((const unsigned*)((const char*)(gbase) + (voff)[_i]), (LAS unsigned*)(lds + (bufoff) + ldsw + _i * 8192), 16, 0, 0); } while (0)
#define PG8_LDA(dst, b, h) do { _Pragma("unroll") for (int m = 0; m < 4; ++m) _Pragma("unroll") for (int k = 0; k < 2; ++k) dst[m][k] = *(const LAS bf16x8*)(lds + PG8_SA(b, h) + aoff + m * 2048 + k * 1024); } while (0)
#define PG8_LDB(dst, b, h) do { _Pragma("unroll") for (int n = 0; n < 2; ++n) _Pragma("unroll") for (int k = 0; k < 2; ++k) dst[n][k] = *(const LAS bf16x8*)(lds + PG8_SB(b, h) + boff + n * 2048 + k * 1024); } while (0)
#define PG8_MMA(ai, bj, At, Bt) do { __builtin_amdgcn_s_setprio(1); _Pragma("unroll") for (int m = 0; m < 4; ++m) _Pragma("unroll") for (int n = 0; n < 2; ++n) _Pragma("unroll") for (int k = 0; k < 2; ++k) \
        acc[ai][bj][m][n] = __builtin_amdgcn_mfma_f32_16x16x32_bf16(Bt[n][k], At[m][k], acc[ai][bj][m][n], 0, 0, 0); __builtin_amdgcn_s_setprio(0); } while (0)
#define PG8_WAIT_V(n) asm volatile("s_waitcnt vmcnt(" #n ")" ::: "memory")
#define PG8_WAIT_L(n) asm volatile("s_waitcnt lgkmcnt(" #n ")" ::: "memory")
#define PG8_BAR __builtin_amdgcn_s_barrier()
#define PG8_SCHED __builtin_amdgcn_sched_barrier(0)
    Unit cur, nxt; int ui = 0;
    if (!next_unit(g, 0, cur)) return;
    f32x4 acc[2][2][4][2];
#pragma unroll
    for (int a = 0; a < 2; ++a)
#pragma unroll
        for (int b = 0; b < 2; ++b)
#pragma unroll
            for (int m = 0; m < 4; ++m)
#pragma unroll
                for (int n = 0; n < 2; ++n) acc[a][b][m][n] = (f32x4){0.f, 0.f, 0.f, 0.f};
    bf16x8 At[4][2], B0[2][2], B1[2][2];
    const char* cA = (const char*)g.A + ((size_t)cur.z * g.zA) * 2 + (size_t)cur.pm * tstepA;
    const char* cB = (const char*)g.Bt + ((size_t)cur.z * g.zB) * 2 + (size_t)cur.pn * tstepB;
    PG8_STAGE(PG8_SB(0, 0), cB, voffB); PG8_STAGE(PG8_SB(0, 1), cB + hstepB, voffB); PG8_STAGE(PG8_SA(0, 0), cA, voffA); PG8_STAGE(PG8_SA(0, 1), cA + hstepA, voffA);
    if (wr == 1) PG8_BAR;
    PG8_WAIT_V(2); PG8_BAR;
    PG8_STAGE(PG8_SB(1, 0), cB + kstepB, voffB); PG8_STAGE(PG8_SA(1, 0), cA + kstepA, voffA); PG8_STAGE(PG8_SB(1, 1), cB + hstepB + kstepB, voffB);
    PG8_WAIT_V(6); PG8_BAR;
    for (;;) {
        const bool has_next = next_unit(g, ui + 1, nxt);
        const char* nA = has_next ? (const char*)g.A + ((size_t)nxt.z * g.zA) * 2 + (size_t)nxt.pm * tstepA : cA;
        const char* nB = has_next ? (const char*)g.Bt + ((size_t)nxt.z * g.zB) * 2 + (size_t)nxt.pn * tstepB : cB;
        unsigned long long kc0 = 0; if (PROBE_CLASS == 9 || PROBE_CLASS == 11 || PROBE_CLASS == 12) kc0 = clock64();
        for (int t = 0; t < nt; t += 2) {
            const bool last = (t == nt - 2);
            const char* a1 = cA + (size_t)(t + 1) * kstepA;
            const char* a2 = last ? nA : cA + (size_t)(t + 2) * kstepA; const char* b2 = last ? nB : cB + (size_t)(t + 2) * kstepB;
            const char* a3 = a2 + kstepA; const char* b3 = b2 + kstepB;
            PG8_LDB(B0, 0, 0); PG8_LDB(B1, 0, 1); PG8_SCHED; PG8_LDA(At, 0, 0); PG8_STAGE(PG8_SA(1, 1), a1 + hstepA, voffA);
            PG8_WAIT_V(8); PG8_WAIT_L(0); PG8_BAR; PG8_MMA(0, 0, At, B0); PG8_MMA(0, 1, At, B1); PG8_BAR; PG8_SCHED;
            PG8_LDA(At, 0, 1); PG8_STAGE(PG8_SB(0, 0), b2, voffB); PG8_STAGE(PG8_SB(0, 1), b2 + hstepB, voffB); PG8_STAGE(PG8_SA(0, 0), a2, voffA);
            PG8_WAIT_V(8); PG8_WAIT_L(0); PG8_BAR; PG8_MMA(1, 0, At, B0); PG8_MMA(1, 1, At, B1); PG8_BAR; PG8_SCHED;
            PG8_LDB(B0, 1, 0); PG8_LDB(B1, 1, 1); PG8_SCHED; PG8_LDA(At, 1, 0); PG8_STAGE(PG8_SA(0, 1), a2 + hstepA, voffA);
            PG8_WAIT_V(8); PG8_WAIT_L(0); PG8_BAR; PG8_MMA(0, 0, At, B0); PG8_MMA(0, 1, At, B1); PG8_BAR; PG8_SCHED;
            PG8_LDA(At, 1, 1); PG8_STAGE(PG8_SB(1, 0), b3, voffB); PG8_STAGE(PG8_SB(1, 1), b3 + hstepB, voffB); PG8_STAGE(PG8_SA(1, 0), a3, voffA);
            PG8_WAIT_V(8); PG8_WAIT_L(0); PG8_BAR; PG8_MMA(1, 0, At, B0); PG8_MMA(1, 1, At, B1); PG8_BAR; PG8_SCHED;
        }
        if (PROBE_CLASS == 9 || (PROBE_CLASS == 11 && ui == 0) || (PROBE_CLASS == 12 && ui >= 3)) { tepi += (clock64() - kc0); g_ktiles += nt; }
        if (wr == 0) PG8_BAR;
        if (PROBE_CLASS == 8) { const unsigned long long e0 = wall_clock64(); E(acc, cur, wr, wc, fr, fq); asm volatile("s_waitcnt vmcnt(0)" ::: "memory"); tepi += wall_clock64() - e0; } else E(acc, cur, wr, wc, fr, fq);
        if (!has_next) break;
#pragma unroll
        for (int a = 0; a < 2; ++a)
#pragma unroll
            for (int b = 0; b < 2; ++b)
#pragma unroll
                for (int m = 0; m < 4; ++m)
#pragma unroll
                    for (int n = 0; n < 2; ++n) acc[a][b][m][n] = (f32x4){0.f, 0.f, 0.f, 0.f};
        cur = nxt; cA = nA; cB = nB; ++ui;
        if (wr == 1) PG8_BAR;
    }
    PG8_WAIT_V(0);
    PG8_BAR;
#undef PG8_SA
#undef PG8_SB
#undef PG8_STAGE
#undef PG8_LDA
#undef PG8_LDB
#undef PG8_MMA
#undef PG8_WAIT_V
#undef PG8_WAIT_L
#undef PG8_BAR
#undef PG8_SCHED
}
}

__device__ __forceinline__ void rows_rstd(const float* rs, int row0, int fq, float (&rstd)[2][4]) {
    f32x4 pr[2][4];
#pragma unroll
    for (int ai = 0; ai < 2; ++ai)
#pragma unroll
        for (int m = 0; m < 4; ++m) pr[ai][m] = *(const f32x4*)(rs + (size_t)(row0 + ai * 128 + m * 16) * 16 + 4 * fq);
#pragma unroll
    for (int ai = 0; ai < 2; ++ai)
#pragma unroll
        for (int m = 0; m < 4; ++m) { float s = (pr[ai][m].x + pr[ai][m].y) + (pr[ai][m].z + pr[ai][m].w); s += __shfl_xor(s, 16); s += __shfl_xor(s, 32);
            rstd[ai][m] = __builtin_amdgcn_rsqf(s * (1.0f / 1024.0f) + 1e-6f); }
}
enum { M_BF16 = 0, M_CMIN = 1, M_RES = 2, M_LRUIN = 3, M_LRUG = 4, M_MLIN = 5 };
struct EP {
    u16 *o0, *o1, *o2, *o3; float* f0;
    const float *xsl, *xsc; float *xdl, *xdc;
    const float *gate, *bias, *q0, *q1, *q2; const u16* bsrc;
    int ldc, pn0;
    const float *ng, *nsc; u16* xb; float* rs;
    const float *rsr, *shw; int shwld;
};
template <int MODE> struct Epi {
    static constexpr bool PERM = (MODE != M_RES);
    EP p;
    __device__ __forceinline__ void operator()(const f32x4 (&acc)[2][2][4][2], const g8::Unit& u, int wr, int wc, int fr, int fq) const {
        const int row0 = u.pm * 256 + wr * 64 + fr;
        if constexpr (MODE == M_RES) {
            const int col0 = u.pn * 256 + wc * 32 + 4 * fq;
            const bool lat = u.pm < 256; const int mb = lat ? (u.pm >> 4) : 16;
            const float* gp = p.gate + (size_t)mb * 6144 + col0;
            const bool wxb = p.xb != nullptr;
            f32x4 gv[2][2], gm[2][2];
#pragma unroll
            for (int bj = 0; bj < 2; ++bj)
#pragma unroll
                for (int n = 0; n < 2; ++n) { gv[bj][n] = *(const f32x4*)(gp + bj * 128 + n * 16);
                    if (wxb) { const f32x4 g4 = *(const f32x4*)(p.ng + col0 + bj * 128 + n * 16), s4 = *(const f32x4*)(p.nsc + (size_t)mb * 6144 + col0 + bj * 128 + n * 16); gm[bj][n] = g4 * (s4 + 1.0f); }
                    else gm[bj][n] = (f32x4){0.f, 0.f, 0.f, 0.f}; }
            const float* xs = lat ? p.xsl : p.xsc; float* xd = lat ? p.xdl : p.xdc; const int rbase = lat ? row0 : row0 - ML;
#pragma unroll
            for (int ai2 = 0; ai2 < 4; ++ai2) { const int ai = ai2 >> 1, mb0 = (ai2 & 1) * 2;
                f32x4 xv[4][2][2];
#pragma unroll
                for (int m = mb0; m < mb0 + 2; ++m) { const size_t off = (size_t)(rbase + ai * 128 + m * 16) * 1024 + col0;
#pragma unroll
                    for (int bj = 0; bj < 2; ++bj)
#pragma unroll
                        for (int n = 0; n < 2; ++n) xv[m][bj][n] = *(const f32x4*)(xs + off + bj * 128 + n * 16); }
#pragma unroll
                for (int m = mb0; m < mb0 + 2; ++m) { const size_t off = (size_t)(rbase + ai * 128 + m * 16) * 1024 + col0; const int row = row0 + ai * 128 + m * 16; float ssq = 0.f;
#pragma unroll
                    for (int bj = 0; bj < 2; ++bj)
#pragma unroll
                        for (int n = 0; n < 2; ++n) { const f32x4 xn = xv[m][bj][n] + gv[bj][n] * acc[ai][bj][m][n];
                            *(f32x4*)(xd + off + bj * 128 + n * 16) = xn;
                            if (wxb) { ssq += (xn.x * xn.x + xn.y * xn.y) + (xn.z * xn.z + xn.w * xn.w); const f32x4 hb = xn * gm[bj][n];
                                u32x2 o; o.x = cvt_pk_bf16(hb.x, hb.y); o.y = cvt_pk_bf16(hb.z, hb.w); *(u32x2*)(p.xb + ablk(row, col0 + bj * 128 + n * 16, 16)) = o; } }
                    if (wxb) { ssq += __shfl_xor(ssq, 16); ssq += __shfl_xor(ssq, 32); if (fq == 0) p.rs[(size_t)row * 16 + u.pn * 4 + wc] = ssq; } }
            }
        } else if constexpr (MODE == M_BF16) {
            const int col0 = (u.pn - p.pn0) * 256 + wc * 32 + 8 * fq, colg = u.pn * 256 + wc * 32 + 8 * fq;
            const int mb = u.pm < 256 ? (u.pm >> 4) : 16;
            f32x4 sv[2][2];
#pragma unroll
            for (int bj = 0; bj < 2; ++bj)
#pragma unroll
                for (int n = 0; n < 2; ++n) sv[bj][n] = *(const f32x4*)(p.shw + (size_t)mb * p.shwld + colg + bj * 128 + 4 * n);
float rstd8[2][4]; rows_rstd(p.rsr, row0, fq, rstd8);
#pragma unroll
            for (int ai = 0; ai < 2; ++ai)
#pragma unroll
                for (int m = 0; m < 4; ++m) { const int row = row0 + ai * 128 + m * 16; const float rstd = rstd8[ai][m]; const int tjl = u.pn - p.pn0, cin = (wc & 1) * 32 + 8 * fq;
#pragma unroll
                    for (int bj = 0; bj < 2; ++bj) { const f32x4 v0 = acc[ai][bj][m][0] * rstd + sv[bj][0], v1 = acc[ai][bj][m][1] * rstd + sv[bj][1];
                        u32x4 w; w.x = cvt_pk_bf16(v0[0], v0[1]); w.y = cvt_pk_bf16(v0[2], v0[3]); w.z = cvt_pk_bf16(v1[0], v1[1]); w.w = cvt_pk_bf16(v1[2], v1[3]);
                        *(u32x4*)(p.o0 + (((size_t)(tjl * 4 + 2 * bj + (wc >> 1)) * MT + row) << 6) + cin) = w; } }
        } else if constexpr (MODE == M_CMIN) {
            const int colg = u.pn * 256 + wc * 32 + 8 * fq;
            const bool isv = u.pn >= 8; u16* base = isv ? p.o1 : p.o0; const int colt = colg - (isv ? 2048 : 0);
            f32x4 bv[2][2];
#pragma unroll
            for (int bj = 0; bj < 2; ++bj)
#pragma unroll
                for (int n = 0; n < 2; ++n) bv[bj][n] = *(const f32x4*)(p.bias + colg + bj * 128 + 4 * n) + *(const f32x4*)(p.shw + (size_t)(u.pm < 256 ? (u.pm >> 4) : 16) * p.shwld + colg + bj * 128 + 4 * n);
float rstd8[2][4]; rows_rstd(p.rsr, row0, fq, rstd8);
#pragma unroll
            for (int ai = 0; ai < 2; ++ai)
#pragma unroll
                for (int m = 0; m < 4; ++m) { const int row = row0 + ai * 128 + m * 16; const float rstd = rstd8[ai][m]; u16* rp = base + (size_t)row * 2048 + colt; float s = 0.f, ss = 0.f;
#pragma unroll
                    for (int bj = 0; bj < 2; ++bj) { f32x4 v0 = acc[ai][bj][m][0] * rstd + bv[bj][0], v1 = acc[ai][bj][m][1] * rstd + bv[bj][1];
#pragma unroll
                        for (int e = 0; e < 4; ++e) { v0[e] = gelu_tanh(v0[e]); v1[e] = gelu_tanh(v1[e]); s += v0[e] + v1[e]; ss += v0[e] * v0[e] + v1[e] * v1[e]; }
                        u32x4 w; w.x = cvt_pk_bf16(v0[0], v0[1]); w.y = cvt_pk_bf16(v0[2], v0[3]); w.z = cvt_pk_bf16(v1[0], v1[1]); w.w = cvt_pk_bf16(v1[2], v1[3]);
                        *(u32x4*)(rp + bj * 128) = w; }
                    if (isv) { s += __shfl_xor(s, 16); s += __shfl_xor(s, 32); ss += __shfl_xor(ss, 16); ss += __shfl_xor(ss, 32);
                        if (fq == 0) *(f32x2*)(p.f0 + ((size_t)row * 32 + (u.pn - 8) * 4 + wc) * 2) = (f32x2){s, ss}; } }
        } else if constexpr (MODE == M_LRUIN) {
            const int colg = u.pn * 256 + wc * 32 + 8 * fq;
            const bool isx = u.pn >= 4; u16* base = isx ? p.o1 : p.o0; const int colt = colg - (isx ? 1024 : 0);
            const int mb = u.pm < 256 ? (u.pm >> 4) : 16;
            f32x4 sv[2][2];
#pragma unroll
            for (int bj = 0; bj < 2; ++bj)
#pragma unroll
                for (int n = 0; n < 2; ++n) sv[bj][n] = *(const f32x4*)(p.shw + (size_t)mb * p.shwld + colg + bj * 128 + 4 * n);
float rstd8[2][4]; rows_rstd(p.rsr, row0, fq, rstd8);
#pragma unroll
            for (int ai = 0; ai < 2; ++ai)
#pragma unroll
                for (int m = 0; m < 4; ++m) { const int row = row0 + ai * 128 + m * 16; const float rstd = rstd8[ai][m]; u16* rp = base + (size_t)row * 1024 + colt;
#pragma unroll
                    for (int bj = 0; bj < 2; ++bj) { f32x4 v0 = acc[ai][bj][m][0] * rstd + sv[bj][0], v1 = acc[ai][bj][m][1] * rstd + sv[bj][1];
                        if (!isx) {
#pragma unroll
                            for (int e = 0; e < 4; ++e) { v0[e] = gelu_tanh(v0[e]); v1[e] = gelu_tanh(v1[e]); } }
                        u32x4 w; w.x = cvt_pk_bf16(v0[0], v0[1]); w.y = cvt_pk_bf16(v0[2], v0[3]); w.z = cvt_pk_bf16(v1[0], v1[1]); w.w = cvt_pk_bf16(v1[2], v1[3]);
                        *(u32x4*)(rp + bj * 128) = w; } }
        } else if constexpr (MODE == M_LRUG) {
            const int h = u.z, d = u.pn >> 1, jb = u.pn & 1;
            const int ch = h * 256 + jb * 128 + wc * 32 + 8 * fq;
            u16* la = p.o0 + (size_t)d * (4 * (SLOT / 2)); u16* bo = p.o1 + (size_t)d * (3 * (SLOT / 2));
#pragma unroll
            for (int n = 0; n < 2; ++n) {
                const int c4 = ch + 4 * n;
                const f32x4 brg = *(const f32x4*)(p.q0 + d * 1024 + c4), big = *(const f32x4*)(p.q1 + d * 1024 + c4), sp4 = *(const f32x4*)(p.q2 + d * 1024 + c4);
#pragma unroll
                for (int ai = 0; ai < 2; ++ai) {
                    u32x2 xr4[4];
#pragma unroll
                    for (int m = 0; m < 4; ++m) xr4[m] = *(const u32x2*)(p.bsrc + (size_t)(row0 + ai * 128 + m * 16) * 1024 + c4);
#pragma unroll
                    for (int m = 0; m < 4; ++m) { const size_t off = (size_t)(row0 + ai * 128 + m * 16) * 1024 + c4;
                        const u32x2 xr = xr4[m]; const float xv[4] = {bf_lo(xr.x), bf_hi(xr.x), bf_lo(xr.y), bf_hi(xr.y)};
                        float lo[4], bb[4];
#pragma unroll
                        for (int e = 0; e < 4; ++e) { const float r = sigmoidf_(acc[ai][0][m][n][e] + brg[e]), ig = sigmoidf_(acc[ai][1][m][n][e] + big[e]);
                            const float lg = -sp4[e] * r; lo[e] = lg; bb[e] = __builtin_amdgcn_sqrtf(fmaxf(1.0f - fexp_(2.0f * lg), 0.f)) * ig * xv[e]; }
                        u32x2 o1; o1.x = cvt_pk_bf16(lo[0], lo[1]); o1.y = cvt_pk_bf16(lo[2], lo[3]); *(u32x2*)(la + off) = o1;
                        u32x2 o2; o2.x = cvt_pk_bf16(bb[0], bb[1]); o2.y = cvt_pk_bf16(bb[2], bb[3]); *(u32x2*)(bo + off) = o2; }
                }
            }
        } else if constexpr (MODE == M_MLIN) {
            const int colg = u.pn * 256 + wc * 32 + 8 * fq;
            const int reg = u.pn < 2 ? 0 : (u.pn < 4 ? 1 : (u.pn < 8 ? 2 : (u.pn < 12 ? 3 : 4)));
            u16* base = reg == 0 ? p.o0 : (reg == 1 ? p.o1 : (reg == 2 ? p.o2 : p.o3));
            const int ld = (reg < 2) ? 512 : 1024; const int colt = colg - (reg == 0 ? 0 : (reg == 1 ? 512 : (reg == 2 ? 1024 : 2048)));
            const int mb = u.pm < 256 ? (u.pm >> 4) : 16;
            f32x4 sv[2][2];
#pragma unroll
            for (int bj = 0; bj < 2; ++bj)
#pragma unroll
                for (int n = 0; n < 2; ++n) sv[bj][n] = *(const f32x4*)(p.shw + (size_t)mb * p.shwld + colg + bj * 128 + 4 * n);
float rstd8[2][4]; rows_rstd(p.rsr, row0, fq, rstd8);
#pragma unroll
            for (int ai = 0; ai < 2; ++ai)
#pragma unroll
                for (int m = 0; m < 4; ++m) { const int row = row0 + ai * 128 + m * 16; const float rstd = rstd8[ai][m];
                    if (reg < 4) { u16* rp = base + (size_t)row * ld + colt;
#pragma unroll
                        for (int bj = 0; bj < 2; ++bj) { f32x4 v0 = acc[ai][bj][m][0] * rstd + sv[bj][0], v1 = acc[ai][bj][m][1] * rstd + sv[bj][1];
                            if (reg == 0) { v0 = v0 * 0.08838834764831845f; v1 = v1 * 0.08838834764831845f; }
                            if (reg == 3) {
#pragma unroll
                                for (int e = 0; e < 4; ++e) { v0[e] = sigmoidf_(v0[e]); v1[e] = sigmoidf_(v1[e]); } }
                            u32x4 w; w.x = cvt_pk_bf16(v0[0], v0[1]); w.y = cvt_pk_bf16(v0[2], v0[3]); w.z = cvt_pk_bf16(v1[0], v1[1]); w.w = cvt_pk_bf16(v1[2], v1[3]);
                            *(u32x4*)(rp + bj * 128) = w; }
                    } else {
                        const int cl = wc * 32 + 8 * fq;
                        if (cl < 16) {
#pragma unroll
                            for (int e = 0; e < 8; ++e) p.f0[(size_t)row * 16 + cl + e] = acc[ai][0][m][e >> 2][e & 3] * rstd + sv[0][e >> 2][e & 3] + p.bias[cl + e]; }
                    } }
        }
    }
};

__device__ __forceinline__ void tr_item(const float* src, int ld, int nvalid, u16* dst, int ldd, LAS float* scr, int lane) {
#pragma unroll
    for (int i = 0; i < 8; ++i) { const int kk = 8 * i + (lane >> 3), c4 = (lane & 7) * 4;
        const f32x4 v = (c4 < nvalid) ? *(const f32x4*)(src + (size_t)kk * ld + c4) : (f32x4){0.f, 0.f, 0.f, 0.f};
        scr[kk * 33 + c4] = v.x; scr[kk * 33 + c4 + 1] = v.y; scr[kk * 33 + c4 + 2] = v.z; scr[kk * 33 + c4 + 3] = v.w; }
    asm volatile("s_waitcnt lgkmcnt(0)" ::: "memory");
    const int c = lane & 7;
#pragma unroll
    for (int j = 0; j < 4; ++j) { const int n = (lane >> 3) + 8 * j; const LAS float* s = scr + (8 * c) * 33 + n;
        u32x4 o; o.x = cvt_pk_bf16(s[0 * 33], s[1 * 33]); o.y = cvt_pk_bf16(s[2 * 33], s[3 * 33]); o.z = cvt_pk_bf16(s[4 * 33], s[5 * 33]); o.w = cvt_pk_bf16(s[6 * 33], s[7 * 33]);
        *(u32x4*)(dst + (size_t)n * ldd + 8 * c) = o; }
    asm volatile("s_waitcnt lgkmcnt(0)" ::: "memory");
}
template <int MAP> __device__ __forceinline__ void transpose_w(const float* src, int K, int ldsrc, int nsrc, u16* dst, int ndst, LAS float* scr, int gw, int ngw, int lane) {
    const int nkb = K / 64, nitems = (ndst / 32) * nkb;
    for (int it = gw; it < nitems; it += ngw) {
        const int nb = it / nkb, kb = it % nkb, n0 = nb * 32, k0 = kb * 64;
        int c0 = n0;
        if (MAP == 1) { const int j = n0 >> 8, w = n0 & 255, q = w >> 6, r = w & 63; c0 = (r < 32) ? (j * 128 + 32 * q) : (FH + j * 128 + 32 * q); }
        int nvalid = nsrc - c0; nvalid = nvalid > 32 ? 32 : nvalid;
        tr_item(src + (size_t)k0 * ldsrc + c0, ldsrc, nvalid, dst + (size_t)n0 * K + k0, K, scr, lane);
    }
}

__device__ __forceinline__ void phase_prologue(LAS unsigned char* lds, const Params& P) {
    const int tid = opaque_tid(), lane = tid & 63, wid = tid >> 6, bid = obid(), nb = ogdim();
    unsigned char* ws = P.ws;
    {
        LAS float* sl = (LAS float*)lds;
        LAS float* red = sl + 17 * 1024;
        for (int i = tid; i < 17 * 1024; i += 512) { const int mb = i >> 10, k = i & 1023; const float v = mb < 16 ? P.c[mb * 1024 + k] : P.c_ctx[k]; sl[i] = siluf_(v); }
        BLOCK_SYNC();
        float* MOD = (float*)(ws + WS_MOD);
        for (int item = bid; item < 4 * 96; item += nb) {
            const int l = item / 96, n0 = (item % 96) * 64, col = tid & 63, kg = tid >> 6;
            float a[17];
#pragma unroll
            for (int i = 0; i < 17; ++i) a[i] = 0.f;
            const float* w = P.mod_w + ((size_t)l * 1024 + kg * 128) * 6144 + n0 + col;
            for (int kk = 0; kk < 128; ++kk) { const float wv = w[(size_t)kk * 6144];
#pragma unroll
                for (int i = 0; i < 17; ++i) a[i] += sl[i * 1024 + kg * 128 + kk] * wv; }
#pragma unroll
            for (int i = 0; i < 17; ++i) red[(kg * 17 + i) * 64 + col] = a[i];
            BLOCK_SYNC();
            for (int o = tid; o < 17 * 64; o += 512) { const int mb = o >> 6, cc = o & 63; float s = P.mod_b[l * 6144 + n0 + cc];
#pragma unroll
                for (int k8 = 0; k8 < 8; ++k8) s += red[(k8 * 17 + mb) * 64 + cc];
                MOD[((size_t)l * 17 + mb) * 6144 + n0 + cc] = s; }
            BLOCK_SYNC();
        }
    }
    BLOCK_SYNC();
    for (int i = bid * 512 + tid; i < 2048; i += nb * 512) ((float*)(ws + WS_SP8))[i] = 8.0f * log1pf(__expf(-P.lru_lambda[i]));
    LAS float* scr = (LAS float*)(lds + wid * 8448);
    const int gw = bid * 8 + wid, ngw = nb * 8;
    for (int l = 0; l < 4; ++l) {
        transpose_w<1>(P.ffn_w_up + (size_t)l * 1024 * F2, 1024, F2, F2, (u16*)(ws + WS_FFN_UP_T + l * SZ_FFN_UP_T), F2, scr, gw, ngw, lane);
        transpose_w<0>(P.ffn_w_down + (size_t)l * FH * 1024, FH, 1024, 1024, (u16*)(ws + WS_FFN_DN_T + l * SZ_FFN_DN_T), 1024, scr, gw, ngw, lane);
    }
    for (int j = 0; j < 2; ++j) {
        transpose_w<0>(P.cm_w_in + (size_t)j * 1024 * 4096, 1024, 4096, 4096, (u16*)(ws + WS_CM_IN_T) + (size_t)j * 4096 * 1024, 4096, scr, gw, ngw, lane);
        transpose_w<0>(P.cm_w_out + (size_t)j * 2048 * 1024, 2048, 1024, 1024, (u16*)(ws + WS_CM_OUT_T) + (size_t)j * 1024 * 2048, 1024, scr, gw, ngw, lane);
    }
    transpose_w<0>(P.lru_w_in, 1024, 2048, 2048, (u16*)(ws + WS_LRU_IN_T), 2048, scr, gw, ngw, lane);
    transpose_w<0>(P.lru_w_out, 1024, 1024, 1024, (u16*)(ws + WS_LRU_OUT_T), 1024, scr, gw, ngw, lane);
    transpose_w<0>(P.ml_w_in, 1024, 3088, 3088, (u16*)(ws + WS_ML_IN_T), 3328, scr, gw, ngw, lane);
    transpose_w<0>(P.ml_w_out, 1024, 1024, 1024, (u16*)(ws + WS_ML_OUT_T), 1024, scr, gw, ngw, lane);
    for (int q = 0; q < 32; ++q) {
        const int h = q >> 3, tn = (q >> 1) & 3, gate = q & 1, d = tn >> 1, jb = tn & 1;
        const float* src = (gate ? P.lru_w_ig : P.lru_w_rg) + (size_t)(d * 4 + h) * 256 * 256 + jb * 128;
        u16* dst = (u16*)(ws + WS_LRU_G_T) + ((size_t)h * 1024 + tn * 256 + gate * 128) * 256;
        transpose_w<0>(src, 256, 256, 128, dst, 128, scr, (gw + q * 16) % ngw, ngw, lane);
    }
}

__device__ __forceinline__ void phase_prenorm(const float* xl, const float* xc, const float* g, const float* modl, int shoff, int scoff, u16* H, int nrows) {
    const int tid_ = opaque_tid(); const int lane = tid_ & 63, gw = obid() * 8 + (tid_ >> 6), ngw = ogdim() * 8;
    for (int r = gw; r < nrows; r += ngw) {
        const bool lat = r < ML; const float* xr = lat ? xl + (size_t)r * 1024 : xc + (size_t)(r - ML) * 1024; const int mb = lat ? (r >> 12) : 16;
        f32x4 v[4]; float ss = 0.f;
#pragma unroll
        for (int j = 0; j < 4; ++j) { v[j] = ((const f32x4*)xr)[lane + 64 * j]; ss += (v[j].x * v[j].x + v[j].y * v[j].y) + (v[j].z * v[j].z + v[j].w * v[j].w); }
        const float rstd = rsqrtf(wave_sum(ss) * (1.0f / 1024.0f) + 1e-6f);
        const float* mp = modl + (size_t)mb * 6144;
#pragma unroll
        for (int j = 0; j < 4; ++j) { const int c = (lane + 64 * j) * 4;
            const f32x4 gg = *(const f32x4*)(g + c), sc = *(const f32x4*)(mp + scoff + c), sh = *(const f32x4*)(mp + shoff + c);
            const f32x4 y = v[j] * rstd * gg; const f32x4 hh = y * (sc + 1.0f) + sh;
            u32x2 o; o.x = cvt_pk_bf16(hh.x, hh.y); o.y = cvt_pk_bf16(hh.z, hh.w);
            *(u32x2*)(H + (size_t)r * 1024 + c) = o; }
    }
}
__device__ __forceinline__ void phase_pre0(const float* xl, const float* xc, const float* g, const float* modl, int scoff, u16* XB, float* RS, int nrows) {
    const int tid_ = opaque_tid(); const int lane = tid_ & 63, gw = obid() * 8 + (tid_ >> 6), ngw = ogdim() * 8;
    for (int r = gw; r < nrows; r += ngw) {
        const bool lat = r < ML; const float* xr = lat ? xl + (size_t)r * 1024 : xc + (size_t)(r - ML) * 1024; const int mb = lat ? (r >> 12) : 16;
        f32x4 v[4]; float ss = 0.f;
#pragma unroll
        for (int j = 0; j < 4; ++j) { v[j] = ((const f32x4*)xr)[lane + 64 * j]; ss += (v[j].x * v[j].x + v[j].y * v[j].y) + (v[j].z * v[j].z + v[j].w * v[j].w); }
        ss = wave_sum(ss);
        if (lane < 16) RS[(size_t)r * 16 + lane] = (lane == 0) ? ss : 0.f;
        const float* mp = modl + (size_t)mb * 6144;
#pragma unroll
        for (int j = 0; j < 4; ++j) { const int c = (lane + 64 * j) * 4;
            const f32x4 gg = *(const f32x4*)(g + c), sc = *(const f32x4*)(mp + scoff + c);
            const f32x4 hh = v[j] * gg * (sc + 1.0f);
            u32x2 o; o.x = cvt_pk_bf16(hh.x, hh.y); o.y = cvt_pk_bf16(hh.z, hh.w);
            *(u32x2*)(XB + ablk(r, c, 16)) = o; }
    }
}
__device__ __forceinline__ void shw_table(LAS unsigned char* lds, const float* modl, int shoff, const u16* Wt, int N, float* out) {
    LAS float* sh = (LAS float*)lds;
    const int tid = opaque_tid(), lane = tid & 63, wid = tid >> 6;
    BLOCK_SYNC();
    for (int i = tid; i < 17 * 1024; i += 512) sh[i] = modl[(size_t)(i >> 10) * 6144 + shoff + (i & 1023)];
    BLOCK_SYNC();
    for (int n = obid() * 8 + wid; n < N; n += ogdim() * 8) {
        float w[16]; { float t8[8]; unpack8(*(const u32x4*)(Wt + (size_t)n * 1024 + lane * 8), t8);
#pragma unroll
            for (int e = 0; e < 8; ++e) w[e] = t8[e];
            unpack8(*(const u32x4*)(Wt + (size_t)n * 1024 + 512 + lane * 8), t8);
#pragma unroll
            for (int e = 0; e < 8; ++e) w[8 + e] = t8[e]; }
        float res = 0.f;
#pragma unroll 1
        for (int mb = 0; mb < 17; ++mb) { const LAS float* s = sh + mb * 1024 + lane * 8; float a = 0.f;
#pragma unroll
            for (int e = 0; e < 8; ++e) a += w[e] * s[e] + w[8 + e] * s[512 + e];
            a = wave_sum(a); if (lane == mb) res = a; }
        if (lane < 17) out[(size_t)lane * N + n] = res;
    }
}
__device__ __forceinline__ void phase_final_norm(float* x, const float* g) {
    const int tid_ = opaque_tid(); const int lane = tid_ & 63, gw = obid() * 8 + (tid_ >> 6), ngw = ogdim() * 8;
    for (int r = gw; r < ML; r += ngw) {
        float* xr = x + (size_t)r * 1024; f32x4 v[4]; float ss = 0.f;
#pragma unroll
        for (int j = 0; j < 4; ++j) { v[j] = ((const f32x4*)xr)[lane + 64 * j]; ss += (v[j].x * v[j].x + v[j].y * v[j].y) + (v[j].z * v[j].z + v[j].w * v[j].w); }
        const float rstd = rsqrtf(wave_sum(ss) * (1.0f / 1024.0f) + 1e-6f);
#pragma unroll
        for (int j = 0; j < 4; ++j) { const int c = (lane + 64 * j) * 4; const f32x4 gg = *(const f32x4*)(g + c); ((f32x4*)xr)[lane + 64 * j] = v[j] * rstd * gg; }
    }
}

__device__ __forceinline__ void phase_cm_spatial(LAS unsigned char* lds, u16* U, const u16* V, const float* pstats, const float* w_s, const float* b_s, const float* v_g, const float* v_b, int nchunks) {
    constexpr int LW = 136;
    LAS u16* VT = (LAS u16*)lds;
    LAS u16* WP = (LAS u16*)(lds + 69632);
    LAS float* mu = (LAS float*)(lds + 104448); LAS float* rs = mu + 128; LAS float* t1 = rs + 128; LAS float* t2 = t1 + 128;
    const int tid = opaque_tid(), lane = tid & 63, w = tid >> 6, fr = lane & 15, fq = lane >> 4;
    for (int item = obid(); item < nchunks * 8; item += ogdim()) {
        const int ck = item >> 3, g = item & 7, r0 = ck * 128;
        if (tid < 128) { const float* ps = pstats + (size_t)(r0 + tid) * 64; float s = 0.f, ss = 0.f;
            for (int i = 0; i < 32; ++i) { s += ps[2 * i]; ss += ps[2 * i + 1]; }
            const float mean = s * (1.0f / 2048.0f); const float var = fmaxf(ss * (1.0f / 2048.0f) - mean * mean, 0.f);
            mu[tid] = mean; rs[tid] = rsqrtf(var + 1e-6f); }
        BLOCK_SYNC();
#pragma unroll
        for (int j = 0; j < 8; ++j) { const int pc = tid + 512 * j, q = pc & 127, c8 = pc >> 7;
            const u32x4 raw = *(const u32x4*)(V + (size_t)(r0 + q) * 2048 + g * 256 + c8 * 8);
            LAS u16* d = VT + (c8 * 8) * LW + q;
            d[0 * LW] = (u16)(raw.x & 0xffffu); d[1 * LW] = (u16)(raw.x >> 16); d[2 * LW] = (u16)(raw.y & 0xffffu); d[3 * LW] = (u16)(raw.y >> 16);
            d[4 * LW] = (u16)(raw.z & 0xffffu); d[5 * LW] = (u16)(raw.z >> 16); d[6 * LW] = (u16)(raw.w & 0xffffu); d[7 * LW] = (u16)(raw.w >> 16); }
        { const int pr = tid >> 2, part = tid & 3; const float* wrow = w_s + ((size_t)g * 128 + pr) * 128 + part * 32; float a1 = 0.f, a2 = 0.f;
            f32x4 wv4[8];
#pragma unroll
            for (int q4 = 0; q4 < 8; ++q4) wv4[q4] = ((const f32x4*)wrow)[q4];
#pragma unroll
            for (int q4 = 0; q4 < 8; ++q4) { const int q = part * 32 + q4 * 4; const f32x4 r4 = *(const LAS f32x4*)(rs + q), m4 = *(const LAS f32x4*)(mu + q);
                const unsigned p01 = cvt_pk_bf16(wv4[q4].x * r4.x, wv4[q4].y * r4.y), p23 = cvt_pk_bf16(wv4[q4].z * r4.z, wv4[q4].w * r4.w);
                *(LAS u32x2*)(WP + pr * LW + q) = (u32x2){p01, p23};
                a1 += (bf_lo(p01) * m4.x + bf_hi(p01) * m4.y) + (bf_lo(p23) * m4.z + bf_hi(p23) * m4.w); a2 += (wv4[q4].x + wv4[q4].y) + (wv4[q4].z + wv4[q4].w); }
            a1 += __shfl_xor(a1, 1); a1 += __shfl_xor(a1, 2); a2 += __shfl_xor(a2, 1); a2 += __shfl_xor(a2, 2);
            if (part == 0) { t1[pr] = a1; t2[pr] = a2; } }
        BLOCK_SYNC();
        f32x4 acc[8][2];
#pragma unroll
        for (int m = 0; m < 8; ++m) { acc[m][0] = (f32x4){0.f, 0.f, 0.f, 0.f}; acc[m][1] = (f32x4){0.f, 0.f, 0.f, 0.f}; }
#pragma unroll 1
        for (int k = 0; k < 4; ++k) {
            bf16x8 Vf[2];
#pragma unroll
            for (int n = 0; n < 2; ++n) Vf[n] = *(const LAS bf16x8*)(VT + (32 * w + 16 * n + fr) * LW + 32 * k + 8 * fq);
#pragma unroll
            for (int m = 0; m < 8; ++m) { const bf16x8 Wf = *(const LAS bf16x8*)(WP + (16 * m + fr) * LW + 32 * k + 8 * fq);
#pragma unroll
                for (int n = 0; n < 2; ++n) acc[m][n] = __builtin_amdgcn_mfma_f32_16x16x32_bf16(Vf[n], Wf, acc[m][n], 0, 0, 0); }
        }
        u32x2 ur8[8][2];
#pragma unroll
        for (int m = 0; m < 8; ++m)
#pragma unroll
            for (int n = 0; n < 2; ++n) ur8[m][n] = *(const u32x2*)(U + (size_t)(r0 + 16 * m + fr) * 2048 + g * 256 + 32 * w + 16 * n + 4 * fq);
        f32x4 vg4[2], vb4[2];
#pragma unroll
        for (int n = 0; n < 2; ++n) { const int cg_ = g * 256 + 32 * w + 16 * n + 4 * fq; vg4[n] = *(const f32x4*)(v_g + cg_); vb4[n] = *(const f32x4*)(v_b + cg_); }
#pragma unroll
        for (int m = 0; m < 8; ++m) { const int pp = 16 * m + fr; const float tt1 = t1[pp], tt2 = t2[pp], bsp = b_s[g * 128 + pp];
#pragma unroll
            for (int n = 0; n < 2; ++n) { const int cg_ = g * 256 + 32 * w + 16 * n + 4 * fq;
                u16* up = U + (size_t)(r0 + pp) * 2048 + cg_; const u32x2 ur = ur8[m][n];
                const float u0 = bf_lo(ur.x), u1 = bf_hi(ur.x), u2 = bf_lo(ur.y), u3 = bf_hi(ur.y);
                const float s0 = vg4[n].x * (acc[m][n][0] - tt1) + vb4[n].x * tt2 + bsp, s1 = vg4[n].y * (acc[m][n][1] - tt1) + vb4[n].y * tt2 + bsp;
                const float s2 = vg4[n].z * (acc[m][n][2] - tt1) + vb4[n].z * tt2 + bsp, s3 = vg4[n].w * (acc[m][n][3] - tt1) + vb4[n].w * tt2 + bsp;
                u32x2 o; o.x = cvt_pk_bf16(u0 * s0, u1 * s1); o.y = cvt_pk_bf16(u2 * s2, u3 * s3); *(u32x2*)up = o; } }
        BLOCK_SYNC();
    }
}

constexpr int CONV_NPRE = 11;
__device__ __forceinline__ void conv_lat_decode(int iu, int ntile, int j0, int& zbase_row, int& band, int& zg, int& c0) {
    const int cq = (iu >> 3) & 3, idx = (iu & 7) + 8 * (iu >> 5), tj = idx % ntile, rest = idx / ntile;
    band = rest & 7; const int b = rest >> 3; zbase_row = b * 4096 + band * 512;
    zg = tj * 4 + cq; c0 = (j0 + tj) * 128 + cq * 32;
}
__device__ __forceinline__ void conv_lat_prefetch(const u16* Z, int ld, int zbase_row, int band, int zg, const float* cw, const float* cb, int c0, int tid,
                                                  const int (&rel)[CONV_NPRE], const int (&flg)[CONV_NPRE], u32x4 (&pre)[CONV_NPRE], float (&wpre)[2]) {
    const u16* zb = Z + (((size_t)zg * MT + zbase_row) << 6);
#pragma unroll
    for (int s = 0; s < CONV_NPRE; ++s) { u32x4 v = (u32x4){0u, 0u, 0u, 0u};
        const bool ok = (flg[s] & 1) && !((flg[s] & 2) && band == 0) && !((flg[s] & 4) && band == 7);
        if (ok) v = *(const u32x4*)(zb + (ptrdiff_t)rel[s]);
        pre[s] = v; }
#pragma unroll
    for (int s = 0; s < 2; ++s) { const int i = tid + 512 * s; float v = 0.f;
        if (i < 9 * 64) { const int tap = i >> 6, ch = i & 63; v = cw[(size_t)tap * F2 + (ch < 32 ? c0 + ch : FH + c0 + ch - 32)]; }
        else if (i < 10 * 64) { const int ch = i & 63; v = cb[ch < 32 ? c0 + ch : FH + c0 + ch - 32]; }
        wpre[s] = v; }
}
__device__ __forceinline__ void phase_ffn_conv(LAS unsigned char* lds, const u16* Z, int ntile, int j0, const float* cw, const float* cb, u16* A2, bool with_ctx, unsigned long long& tpr) {
    LAS u16* T = (LAS u16*)lds;
    LAS float* Wc = (LAS float*)(lds + 100352);
    const int tid = opaque_tid();
    const int n_lat = 16 * 8 * ntile * 4, n_all = n_lat + (with_ctx ? 16 * ntile * 4 : 0);
    const int ld = ntile * 256;
    u32x4 pre[CONV_NPRE]; float wpre[2];
    {
        int rel[CONV_NPRE], loff[CONV_NPRE], flg[CONV_NPRE];
#pragma unroll
        for (int s = 0; s < CONV_NPRE; ++s) { const int pc = tid + 512 * s; const int o = pc & 7, pos = pc >> 3, lr = pos / 66, lc = pos - lr * 66;
            const bool ex = pc < 10 * 66 * 8;
            rel[s] = ((lr - 1) * 64 + (lc - 1)) * 64 + o * 8; loff[s] = (pos * 64 + (o & 3) * 16 + (o >> 2) * 8);
            flg[s] = ((ex && lc >= 1 && lc <= 64) ? 1 : 0) | (lr == 0 ? 2 : 0) | (lr == 9 ? 4 : 0) | (ex ? 8 : 0); }
        const int oct = tid & 3, col = (tid >> 2) & 63, rh = tid >> 8;
        const int tb = ((4 * rh) * 66 + col) * 64 + oct * 16;
        int it = obid(); const int G = ogdim();
        int zrow = 0, band = 0, zg = 0, c0 = 0;
        if (it < n_lat) { conv_lat_decode(it, ntile, j0, zrow, band, zg, c0); conv_lat_prefetch(Z, ld, zrow, band, zg, cw, cb, c0, tid, rel, flg, pre, wpre); }
        while (it < n_lat) {
            unsigned long long q0 = 0; if (PROBE_CLASS >= 14 && PROBE_CLASS <= 16) q0 = wall_clock64();
#pragma unroll
            for (int s = 0; s < CONV_NPRE; ++s) if (flg[s] & 8) *(LAS u32x4*)(T + loff[s]) = pre[s];
#pragma unroll
            for (int s = 0; s < 2; ++s) { const int i = tid + 512 * s; if (i < 10 * 64) Wc[i] = wpre[s]; }
            BLOCK_SYNC();
            unsigned long long q1 = 0; if (PROBE_CLASS >= 14 && PROBE_CLASS <= 16) { q1 = wall_clock64(); if (PROBE_CLASS == 14) tpr += q1 - q0; }
            const int crow = zrow, cc0 = c0;
            const int nxt = it + G;
            if (nxt < n_lat) { conv_lat_decode(nxt, ntile, j0, zrow, band, zg, c0); conv_lat_prefetch(Z, ld, zrow, band, zg, cw, cb, c0, tid, rel, flg, pre, wpre); }
            float gres[4][8];
#pragma unroll
            for (int half = 0; half < 2; ++half) {
                float acc[4][8];
#pragma unroll
                for (int t = 0; t < 4; ++t)
#pragma unroll
                    for (int e = 0; e < 8; ++e) acc[t][e] = Wc[576 + half * 32 + oct * 8 + e];
#pragma unroll 1
                for (int dj = 0; dj < 3; ++dj) {
                    float w[3][8];
#pragma unroll
                    for (int di = 0; di < 3; ++di)
#pragma unroll
                        for (int e = 0; e < 8; ++e) w[di][e] = Wc[(di * 3 + dj) * 64 + half * 32 + oct * 8 + e];
                    u32x4 raw[6];
#pragma unroll
                    for (int rr = 0; rr < 6; ++rr) raw[rr] = *(const LAS u32x4*)(T + tb + (rr * 66 + dj) * 64 + half * 8);
#pragma unroll
                    for (int rr = 0; rr < 6; ++rr) { float zf[8]; unpack8(raw[rr], zf);
#pragma unroll
                        for (int di = 0; di < 3; ++di) { const int t = rr - di; if (t >= 0 && t < 4) {
#pragma unroll
                            for (int e = 0; e < 8; ++e) acc[t][e] += w[di][e] * zf[e]; } } }
                }
                if (half == 0) {
#pragma unroll
                    for (int t = 0; t < 4; ++t)
#pragma unroll
                        for (int e = 0; e < 8; ++e) gres[t][e] = acc[t][e];
                } else {
#pragma unroll
                    for (int t = 0; t < 4; ++t) { float o8[8];
#pragma unroll
                        for (int e = 0; e < 8; ++e) o8[e] = siluf_(gres[t][e]) * acc[t][e];
                        *(u32x4*)(A2 + (size_t)(crow + (4 * rh + t) * 64 + col) * FH + cc0 + oct * 8) = pack8(o8); }
                }
            }
            unsigned long long q2 = 0; if (PROBE_CLASS >= 15 && PROBE_CLASS <= 16) { q2 = wall_clock64(); if (PROBE_CLASS == 15) tpr += q2 - q1; }
            BLOCK_SYNC();
            if (PROBE_CLASS == 16) tpr += wall_clock64() - q2;
            it = nxt;
        }
    }
    {
        const int oct = tid & 3, tk = tid >> 2, G = ogdim();
        const int n_ctx = n_all - n_lat;
        int it = obid();
        while (it < n_ctx) {
            const int cq = (it >> 3) & 3, idx = (it & 7) + 8 * (it >> 5), tj = idx % ntile, b = idx / ntile;
            const int base_row = ML + b * 256, c0 = (j0 + tj) * 128 + cq * 32;
            const u16* zb = Z + (((size_t)(tj * 4 + cq) * MT + base_row) << 6);
#pragma unroll
            for (int s = 0; s < 5; ++s) { const int pc = tid + 512 * s, o = pc & 7, lc = pc >> 3; u32x4 v = (u32x4){0u, 0u, 0u, 0u};
                if (pc < 258 * 8) { if (lc >= 1 && lc <= 256) v = *(const u32x4*)(zb + (lc - 1) * 64 + o * 8);
                    *(LAS u32x4*)(T + (lc * 64 + (o & 3) * 16 + (o >> 2) * 8)) = v; } }
#pragma unroll
            for (int s = 0; s < 2; ++s) { const int i = tid + 512 * s;
                if (i < 9 * 64) { const int tap = i >> 6, ch = i & 63; Wc[i] = cw[(size_t)tap * F2 + (ch < 32 ? c0 + ch : FH + c0 + ch - 32)]; }
                else if (i < 10 * 64) { const int ch = i & 63; Wc[i] = cb[ch < 32 ? c0 + ch : FH + c0 + ch - 32]; } }
            BLOCK_SYNC();
            float ag[2][8], au[2][8];
#pragma unroll
            for (int itr = 0; itr < 2; ++itr)
#pragma unroll
                for (int e = 0; e < 8; ++e) { ag[itr][e] = Wc[576 + oct * 8 + e]; au[itr][e] = Wc[576 + 32 + oct * 8 + e]; }
#pragma unroll
            for (int dj = 0; dj < 3; ++dj) { const int tap = 3 + dj;
                float wg[8], wu[8];
#pragma unroll
                for (int e = 0; e < 8; ++e) { wg[e] = Wc[tap * 64 + oct * 8 + e]; wu[e] = Wc[tap * 64 + 32 + oct * 8 + e]; }
#pragma unroll
                for (int itr = 0; itr < 2; ++itr) { const int col = itr * 128 + tk;
                    const LAS u16* tp = T + ((col + dj) * 64 + oct * 16);
                    float zgv[8], zuv[8]; unpack8(*(const LAS u32x4*)tp, zgv); unpack8(*(const LAS u32x4*)(tp + 8), zuv);
#pragma unroll
                    for (int e = 0; e < 8; ++e) { ag[itr][e] += wg[e] * zgv[e]; au[itr][e] += wu[e] * zuv[e]; } }
            }
#pragma unroll
            for (int itr = 0; itr < 2; ++itr) { const int col = itr * 128 + tk; float o8[8];
#pragma unroll
                for (int e = 0; e < 8; ++e) o8[e] = siluf_(ag[itr][e]) * au[itr][e];
                *(u32x4*)(A2 + (size_t)(base_row + col) * FH + c0 + oct * 8) = pack8(o8); }
            BLOCK_SYNC();
            it += G;
        }
    }
}

__device__ __forceinline__ void phase_lru_conv(const u16* XR, const float* cw  , const float* cb, u16* XCV) {
    const size_t total = (size_t)MT * 128, stride = (size_t)ogdim() * 512;
    const int tid_ = opaque_tid();
    for (size_t idx = (size_t)obid() * 512 + tid_; idx < total; idx += stride) {
        const int r = (int)(idx >> 7), oct = (int)(idx & 127), c = oct * 8;
        int t, len; if (r < ML) { t = r & 4095; len = 4096; } else { t = (r - ML) & 255; len = 256; }
        float a[8];
#pragma unroll
        for (int e = 0; e < 8; ++e) a[e] = cb[c + e];
#pragma unroll
        for (int k = 0; k < 4; ++k) { const int tt = t + k - 2; if (tt >= 0 && tt < len) { float xv[8]; unpack8(*(const u32x4*)(XR + (size_t)(r + k - 2) * 1024 + c), xv);
#pragma unroll
            for (int e = 0; e < 8; ++e) a[e] += cw[k * 1024 + c + e] * xv[e]; } }
        *(u32x4*)(XCV + (size_t)r * 1024 + c) = pack8(a);
    }
}

__device__ __forceinline__ void phase_lru_scanA(const u16* LA0, const u16* B0, const u16* LA1, const u16* B1, float* SEG) {
    const int tid = opaque_tid();
    for (int it = obid(); it < 272; it += ogdim()) {
        const int gt = it * 512 + tid, oct = gt & 127, dir = (gt >> 7) & 1, sid = gt >> 8;
        const u16* la = (dir ? LA1 : LA0) + (size_t)sid * 128 * 1024 + oct * 8; const u16* bb = (dir ? B1 : B0) + (size_t)sid * 128 * 1024 + oct * 8;
        float ps[8], e[8];
#pragma unroll
        for (int c = 0; c < 8; ++c) { ps[c] = 0.f; e[c] = 0.f; }
#pragma unroll 8
        for (int i = 0; i < 128; ++i) { const int t = dir ? 127 - i : i; float lg[8], bv[8]; unpack8(*(const u32x4*)(la + (size_t)t * 1024), lg); unpack8(*(const u32x4*)(bb + (size_t)t * 1024), bv);
#pragma unroll
            for (int c = 0; c < 8; ++c) { ps[c] += lg[c]; e[c] = __expf(lg[c]) * e[c] + bv[c]; } }
        float* so = SEG + (((size_t)dir * 544 + sid) * 1024 + oct * 8) * 2;
#pragma unroll
        for (int c = 0; c < 8; c += 2) *(f32x4*)(so + c * 2) = (f32x4){ps[c], e[c], ps[c + 1], e[c + 1]};
    }
}
__device__ __forceinline__ void lru_carry(const float* SEG, int sid, int dir, int oct, float (&st)[8]) {
    int b, pos;
    if (sid >= 512) { b = (sid - 512) >> 1; const int s = (sid - 512) & 1; pos = dir ? 1 - s : s; }
    else { b = sid >> 5; const int s = sid & 31; pos = 2 + (dir ? 31 - s : s); }
#pragma unroll
    for (int c = 0; c < 8; ++c) st[c] = 0.f;
    for (int p = 0; p < pos; ++p) {
        int ps_;
        if (p < 2) ps_ = 512 + 2 * b + (dir ? 1 - p : p); else ps_ = b * 32 + (dir ? 31 - (p - 2) : (p - 2));
        const float* so = SEG + (((size_t)dir * 544 + ps_) * 1024 + oct * 8) * 2;
#pragma unroll
        for (int c = 0; c < 8; c += 2) { const f32x4 v = *(const f32x4*)(so + c * 2); st[c] = __expf(v.x) * st[c] + v.y; st[c + 1] = __expf(v.z) * st[c + 1] + v.w; }
    }
}
__device__ __forceinline__ void phase_lru_scanC(const u16* LA0, u16* B0, const u16* LA1, const u16* B1, const float* SEG, const u16* Y, u16* G) {
    const int tid = opaque_tid();
    for (int it = obid(); it < 136; it += ogdim()) {
        const int gt = it * 512 + tid, oct = gt & 127, sid = gt >> 7; const size_t base = (size_t)sid * 128 * 1024 + oct * 8;
        float h[8];
        lru_carry(SEG, sid, 0, oct, h);
#pragma unroll 1
        for (int t0 = 0; t0 < 128; t0 += 8) { u32x4 la8[8], b8[8];
#pragma unroll
            for (int k = 0; k < 8; ++k) { const size_t o = base + (size_t)(t0 + k) * 1024; la8[k] = *(const u32x4*)(LA0 + o); b8[k] = *(const u32x4*)(B0 + o); }
#pragma unroll
            for (int k = 0; k < 8; ++k) { const size_t o = base + (size_t)(t0 + k) * 1024; float lg[8], bv[8]; unpack8(la8[k], lg); unpack8(b8[k], bv);
#pragma unroll
                for (int c = 0; c < 8; ++c) h[c] = __expf(lg[c]) * h[c] + bv[c];
                *(u32x4*)(B0 + o) = pack8(h); } }
        lru_carry(SEG, sid, 1, oct, h);
#pragma unroll 1
        for (int i0 = 0; i0 < 128; i0 += 4) { u32x4 la4[4], b4[4], hf4[4], y4[4];
#pragma unroll
            for (int k = 0; k < 4; ++k) { const size_t o = base + (size_t)(127 - i0 - k) * 1024; la4[k] = *(const u32x4*)(LA1 + o); b4[k] = *(const u32x4*)(B1 + o); hf4[k] = *(const u32x4*)(B0 + o); y4[k] = *(const u32x4*)(Y + o); }
#pragma unroll
            for (int k = 0; k < 4; ++k) { const size_t o = base + (size_t)(127 - i0 - k) * 1024; float lg[8], bv[8], hf[8], yv[8], g8[8];
                unpack8(la4[k], lg); unpack8(b4[k], bv); unpack8(hf4[k], hf); unpack8(y4[k], yv);
#pragma unroll
                for (int c = 0; c < 8; ++c) { h[c] = __expf(lg[c]) * h[c] + bv[c]; g8[c] = (hf[c] + h[c]) * yv[c]; }
                *(u32x4*)(G + o) = pack8(g8); } }
    }
}

__device__ __forceinline__ void phase_mlstm(LAS unsigned char* lds, const u16* Q, const u16* Kx, const u16* V, const float* gates, u16* HF, u16* HB) {
    constexpr int LW = 136;
    LAS u16* R1 = (LAS u16*)lds;
    LAS u16* R2 = R1 + 128 * LW;
    LAS u16* VTs = R2 + 128 * LW;
    LAS u16* CTs = VTs + 128 * LW;
    LAS float* fb = (LAS float*)(CTs + 128 * LW);
    LAS float *lfv = fb, *igv = fb + 128, *bcum = fb + 256, *mtv = fb + 384, *iwv = fb + 512, *wv = fb + 640, *nvec = fb + 768, *qn = fb + 896, *den = fb + 1024, *rs2 = fb + 1152;
    const int tid = opaque_tid(), lane = tid & 63, wid = tid >> 6, wr = wid >> 1, wc = wid & 1, fr = lane & 15, fq = lane >> 4;
    for (int item = obid(); item < 256; item += ogdim()) {
        const int half = item & 1, dir = (item >> 1) & 1, h = (item >> 2) & 3, b = item >> 4;
        u16* HO = dir ? HB : HF;
        f32x4 accC[2][4];
#pragma unroll
        for (int a = 0; a < 2; ++a)
#pragma unroll
            for (int n = 0; n < 4; ++n) accC[a][n] = (f32x4){0.f, 0.f, 0.f, 0.f};
        for (int i = tid; i < 128 * LW / 2; i += 512) ((LAS unsigned*)CTs)[i] = 0u;
        if (tid < 128) nvec[tid] = 0.f;
        float mstate = 0.f;
        BLOCK_SYNC();
        for (int step = 0; step < 34; ++step) {
            int base;
            if (step < 2) { const int cc = dir ? 1 - step : step; base = ML + b * 256 + cc * 128; }
            else { const int lc = step - 2, cc = dir ? 31 - lc : lc; base = b * 4096 + cc * 128; }
            u32x4 kreg[4];
#pragma unroll
            for (int j = 0; j < 4; ++j) { const int pc = tid + 512 * j, i = pc & 127, c8 = pc >> 7; const size_t row = (size_t)base + (dir ? 127 - i : i);
                const u32x4 q16 = *(const u32x4*)(Q + row * 512 + h * 128 + c8 * 8); *(LAS u32x4*)(R1 + i * LW + c8 * 8) = q16;
                kreg[j] = *(const u32x4*)(Kx + row * 512 + h * 128 + c8 * 8); *(LAS u32x4*)(R2 + i * LW + c8 * 8) = kreg[j];
                const u32x4 raw = *(const u32x4*)(V + row * 1024 + h * 256 + half * 128 + c8 * 8);
                LAS u16* d = VTs + (c8 * 8) * LW + i;
                d[0 * LW] = (u16)(raw.x & 0xffffu); d[1 * LW] = (u16)(raw.x >> 16); d[2 * LW] = (u16)(raw.y & 0xffffu); d[3 * LW] = (u16)(raw.y >> 16);
                d[4 * LW] = (u16)(raw.z & 0xffffu); d[5 * LW] = (u16)(raw.z >> 16); d[6 * LW] = (u16)(raw.w & 0xffffu); d[7 * LW] = (u16)(raw.w >> 16); }
            if (tid < 128) { const size_t row = (size_t)base + (dir ? 127 - tid : tid); igv[tid] = gates[row * 16 + dir * 8 + h];
                const float f = gates[row * 16 + dir * 8 + 4 + h]; lfv[tid] = fminf(f, 0.f) - log1pf(__expf(-fabsf(f))); }
            BLOCK_SYNC();
            if (tid < 64) {
                const float l0 = lfv[2 * tid], l1 = lfv[2 * tid + 1], i0 = igv[2 * tid], i1 = igv[2 * tid + 1];
                float ps = l0 + l1;
#pragma unroll
                for (int o = 1; o < 64; o <<= 1) { const float v = __shfl_up(ps, o); if (tid >= o) ps += v; }
                const float b1 = ps, b0 = ps - l1;
                const float g0 = i0 - b0, g1 = i1 - b1;
                float pmx = fmaxf(g0, g1);
#pragma unroll
                for (int o = 1; o < 64; o <<= 1) { const float v = __shfl_up(pmx, o); if (tid >= o) pmx = fmaxf(pmx, v); }
                float pprev = __shfl_up(pmx, 1); if (tid == 0) pprev = -INFINITY;
                const float pm0 = fmaxf(pprev, g0), pm1 = pmx;
                const float mt0 = b0 + fmaxf(mstate, pm0), mt1 = b1 + fmaxf(mstate, pm1);
                bcum[2 * tid] = b0; bcum[2 * tid + 1] = b1; mtv[2 * tid] = mt0; mtv[2 * tid + 1] = mt1;
                iwv[2 * tid] = __expf(b0 + mstate - mt0); iwv[2 * tid + 1] = __expf(b1 + mstate - mt1);
            } else if (tid >= 128 && tid < 256) { const int t = tid - 128; float dq = 0.f;
#pragma unroll 2
                for (int c8 = 0; c8 < 16; ++c8) { float qv[8]; unpack8(*(const LAS u32x4*)(R1 + t * LW + c8 * 8), qv);
#pragma unroll
                    for (int e = 0; e < 8; ++e) dq += qv[e] * nvec[c8 * 8 + e]; }
                qn[t] = dq; }
            BLOCK_SYNC();
            const float m_new = mtv[127], b_end = bcum[127], decay = __expf(b_end + mstate - m_new);
            if (tid < 128) wv[tid] = __expf(b_end - bcum[tid] + igv[tid] - m_new);
            f32x4 accS[2][4], accH[2][4];
#pragma unroll
            for (int a = 0; a < 2; ++a)
#pragma unroll
                for (int n = 0; n < 4; ++n) { accS[a][n] = (f32x4){0.f, 0.f, 0.f, 0.f}; accH[a][n] = (f32x4){0.f, 0.f, 0.f, 0.f}; }
#pragma unroll 1
            for (int k = 0; k < 4; ++k) {
                bf16x8 Qf[2];
#pragma unroll
                for (int a = 0; a < 2; ++a) Qf[a] = *(const LAS bf16x8*)(R1 + (32 * wr + 16 * a + fr) * LW + 32 * k + 8 * fq);
#pragma unroll
                for (int n = 0; n < 4; ++n) { const bf16x8 Kf = *(const LAS bf16x8*)(R2 + (64 * wc + 16 * n + fr) * LW + 32 * k + 8 * fq);
#pragma unroll
                    for (int a = 0; a < 2; ++a) accS[a][n] = __builtin_amdgcn_mfma_f32_16x16x32_bf16(Kf, Qf[a], accS[a][n], 0, 0, 0); }
#pragma unroll
                for (int n = 0; n < 4; ++n) { const bf16x8 Cf = *(const LAS bf16x8*)(CTs + (64 * wc + 16 * n + fr) * LW + 32 * k + 8 * fq);
#pragma unroll
                    for (int a = 0; a < 2; ++a) accH[a][n] = __builtin_amdgcn_mfma_f32_16x16x32_bf16(Cf, Qf[a], accH[a][n], 0, 0, 0); }
            }
            BLOCK_SYNC();
#pragma unroll
            for (int a = 0; a < 2; ++a) { const int t = 32 * wr + 16 * a + fr; const float bt = bcum[t], mtt = mtv[t]; float rsum = 0.f;
#pragma unroll
                for (int n = 0; n < 4; ++n) { const int s0 = 64 * wc + 16 * n + 4 * fq; float sv[4];
#pragma unroll
                    for (int j = 0; j < 4; ++j) { const int s = s0 + j; const float dwv = (s <= t) ? __expf(bt - bcum[s] + igv[s] - mtt) : 0.f; sv[j] = accS[a][n][j] * dwv; rsum += sv[j]; }
                    u32x2 o; o.x = cvt_pk_bf16(sv[0], sv[1]); o.y = cvt_pk_bf16(sv[2], sv[3]); *(LAS u32x2*)(R2 + t * LW + s0) = o; }
                rsum += __shfl_xor(rsum, 16); rsum += __shfl_xor(rsum, 32); if (fq == 0) rs2[t * 2 + wc] = rsum; }
#pragma unroll
            for (int j = 0; j < 4; ++j) { const int pc = tid + 512 * j, i = pc & 127, c8 = pc >> 7; const float wgt = wv[i]; float kv[8]; unpack8(kreg[j], kv);
                LAS u16* d = R1 + (c8 * 8) * LW + i;
#pragma unroll
                for (int e = 0; e < 8; ++e) d[e * LW] = f2bf(kv[e] * wgt); }
            BLOCK_SYNC();
            if (tid < 128) { float sn = 0.f;
#pragma unroll 2
                for (int c8 = 0; c8 < 16; ++c8) { float kv[8]; unpack8(*(const LAS u32x4*)(R1 + tid * LW + c8 * 8), kv);
#pragma unroll
                    for (int e = 0; e < 8; ++e) sn += kv[e]; }
                nvec[tid] = decay * nvec[tid] + sn;
            } else if (tid < 256) { const int t = tid - 128; den[t] = iwv[t] * qn[t] + rs2[2 * t] + rs2[2 * t + 1]; }
#pragma unroll
            for (int a = 0; a < 2; ++a) { const float iw = iwv[32 * wr + 16 * a + fr];
#pragma unroll
                for (int n = 0; n < 4; ++n) { accH[a][n] = accH[a][n] * iw; accC[a][n] = accC[a][n] * decay; } }
#pragma unroll 1
            for (int k = 0; k < 4; ++k) {
                bf16x8 Sf[2], VTf[2];
#pragma unroll
                for (int a = 0; a < 2; ++a) { Sf[a] = *(const LAS bf16x8*)(R2 + (32 * wr + 16 * a + fr) * LW + 32 * k + 8 * fq); VTf[a] = *(const LAS bf16x8*)(VTs + (32 * wr + 16 * a + fr) * LW + 32 * k + 8 * fq); }
#pragma unroll
                for (int n = 0; n < 4; ++n) { const bf16x8 Vf = *(const LAS bf16x8*)(VTs + (64 * wc + 16 * n + fr) * LW + 32 * k + 8 * fq);
                    const bf16x8 KTf = *(const LAS bf16x8*)(R1 + (64 * wc + 16 * n + fr) * LW + 32 * k + 8 * fq);
#pragma unroll
                    for (int a = 0; a < 2; ++a) { accH[a][n] = __builtin_amdgcn_mfma_f32_16x16x32_bf16(Vf, Sf[a], accH[a][n], 0, 0, 0);
                        accC[a][n] = __builtin_amdgcn_mfma_f32_16x16x32_bf16(KTf, VTf[a], accC[a][n], 0, 0, 0); } }
            }
            BLOCK_SYNC();
#pragma unroll
            for (int a = 0; a < 2; ++a) { const int t = 32 * wr + 16 * a + fr; const float dn = fmaxf(fabsf(den[t]), __expf(-mtv[t])); const float inv = __builtin_amdgcn_rcpf(dn);
                const size_t row = (size_t)base + (dir ? 127 - t : t);
#pragma unroll
                for (int n = 0; n < 4; ++n) { const int e0 = 64 * wc + 16 * n + 4 * fq;
                    u32x2 o; o.x = cvt_pk_bf16(accH[a][n][0] * inv, accH[a][n][1] * inv); o.y = cvt_pk_bf16(accH[a][n][2] * inv, accH[a][n][3] * inv);
                    *(u32x2*)(HO + row * 1024 + h * 256 + half * 128 + e0) = o;
                    u32x2 cpk; cpk.x = cvt_pk_bf16(accC[a][n][0], accC[a][n][1]); cpk.y = cvt_pk_bf16(accC[a][n][2], accC[a][n][3]);
                    *(LAS u32x2*)(CTs + (32 * wr + 16 * a + fr) * LW + e0) = cpk; } }
            mstate = m_new;
            BLOCK_SYNC();
        }
    }
}
__device__ __forceinline__ void phase_ml_readout(const u16* HF, const u16* HB, const u16* O, const float* ng, u16* G) {
    const int tid_ = opaque_tid(); const int lane = tid_ & 63, gw = obid() * 8 + (tid_ >> 6), ngw = ogdim() * 8;
    for (int r = gw; r < MT; r += ngw) { const size_t off = (size_t)r * 1024 + lane * 16;
        float hs[16], a[8], bq[8];
        unpack8(*(const u32x4*)(HF + off), a); unpack8(*(const u32x4*)(HB + off), bq);
#pragma unroll
        for (int e = 0; e < 8; ++e) hs[e] = a[e] + bq[e];
        unpack8(*(const u32x4*)(HF + off + 8), a); unpack8(*(const u32x4*)(HB + off + 8), bq);
#pragma unroll
        for (int e = 0; e < 8; ++e) hs[8 + e] = a[e] + bq[e];
        float ss = 0.f;
#pragma unroll
        for (int e = 0; e < 16; ++e) ss += hs[e] * hs[e];
        ss += __shfl_xor(ss, 1); ss += __shfl_xor(ss, 2); ss += __shfl_xor(ss, 4); ss += __shfl_xor(ss, 8);
        const float rstd = __builtin_amdgcn_rsqf(ss * (1.0f / 256.0f) + 1e-6f);
        float o0[8], o1[8], g0[8], g1[8];
        unpack8(*(const u32x4*)(O + off), o0); unpack8(*(const u32x4*)(O + off + 8), o1);
#pragma unroll
        for (int e = 0; e < 8; ++e) { g0[e] = o0[e] * hs[e] * rstd * ng[lane * 16 + e]; g1[e] = o1[e] * hs[8 + e] * rstd * ng[lane * 16 + 8 + e]; }
        *(u32x4*)(G + off) = pack8(g0); *(u32x4*)(G + off + 8) = pack8(g1);
    }
}


#define XB_TMO      128
#define XB_XCNT(j)  (256  + 64 * (j))
#define XB_XSUB(j)  (1280 + 64 * (j))
#define XB_XGEN(j)  (2304 + 64 * (j))
#define XB_TOP      3328
#define XB_TOPGEN   3392
#define XCD_BAR_WORDS 3456
#define XB_SPIN_CAP (1u << 22)
__device__ __forceinline__ unsigned xb_ld(unsigned* p)              { return __hip_atomic_load(p, __ATOMIC_RELAXED, __HIP_MEMORY_SCOPE_AGENT); }
__device__ __forceinline__ unsigned xb_add(unsigned* p, unsigned v) { return __hip_atomic_fetch_add(p, v, __ATOMIC_RELAXED, __HIP_MEMORY_SCOPE_AGENT); }
__device__ __forceinline__ unsigned xb_xcc_id() { return (unsigned)__builtin_amdgcn_s_getreg((3 << 11) | 20) & 0xFu; }
#define XB_SPIN(cond, bar) do { unsigned _sp = 0; while (cond) { __builtin_amdgcn_s_sleep(1); \
    if ((++_sp & 255u) == 0u) { if (xb_ld(&(bar)[XB_TMO])) break; if (_sp > XB_SPIN_CAP) { atomicAdd(&(bar)[XB_TMO], 1u); break; } } } } while (0)
__device__ __forceinline__ void xcd_barrier_complete(unsigned* bar, unsigned x, unsigned& nloc, unsigned& nx) {
    const unsigned G = gridDim.x * gridDim.y * gridDim.z;
    unsigned sum, cnt, mine, sp = 0u;
    for (;;) {
        sum = 0u; cnt = 0u; mine = 0u;
#pragma unroll
        for (unsigned j = 0; j < 16; ++j) { const unsigned c = xb_ld(&bar[XB_XCNT(j)]); sum += c; cnt += (c > 0u) ? 1u : 0u; mine = (j == x) ? c : mine; }
        if (sum == G) break;
        __builtin_amdgcn_s_sleep(1);
        if ((++sp & 255u) == 0u) { if (xb_ld(&bar[XB_TMO])) break; if (sp > XB_SPIN_CAP) { atomicAdd(&bar[XB_TMO], 1u); break; } }
    }
    nloc = mine > 0u ? mine : 1u; nx = cnt > 0u ? cnt : 1u;
}
__device__ __forceinline__ void xcd_barrier(unsigned* bar, volatile LAS unsigned* st) {
    asm volatile("s_waitcnt vmcnt(0)" ::: "memory");
    __syncthreads();
    if (threadIdx.x == 0) {
        const unsigned x = xb_xcc_id();
        __builtin_amdgcn_s_waitcnt(0);
        unsigned nloc = st[0], nx = st[1];
        if (nloc == 0u) { xcd_barrier_complete(bar, x, nloc, nx); st[0] = nloc; st[1] = nx; }
        const unsigned old = xb_add(&bar[XB_XSUB(x)], 1u);
        const unsigned gen = old / nloc;
        if (old + 1u == (gen + 1u) * nloc) {
            __builtin_amdgcn_fence(__ATOMIC_RELEASE, "agent");
            asm volatile("s_waitcnt vmcnt(0)" ::: "memory");
            const unsigned og = xb_add(&bar[XB_TOP], 1u);
            const unsigned tg = og / nx;
            if (og + 1u == (tg + 1u) * nx) xb_add(&bar[XB_TOPGEN], 1u);
            else XB_SPIN(xb_ld(&bar[XB_TOPGEN]) == tg, bar);
            __builtin_amdgcn_fence(__ATOMIC_ACQUIRE, "agent");
            xb_add(&bar[XB_XGEN(x)], 1u);
            asm volatile("s_waitcnt vmcnt(0)" ::: "memory");
        } else {
            XB_SPIN(xb_ld(&bar[XB_XGEN(x)]) == gen, bar);
            __builtin_amdgcn_fence(__ATOMIC_ACQUIRE, "agent");
            asm volatile("s_waitcnt vmcnt(0)" ::: "memory");
        }
    }
    __syncthreads();
}

constexpr int PTAB_OFF = LDS_BYTES - 512;
#define SYNC0(c) do { grid.sync(); if (PROBE_CLASS) { const unsigned long long _n = wall_clock64(); if (PROBE_CLASS == (c)) tacc += _n - pt0; pt0 = _n; if (PROBE_CLASS == 10) { cyc0 = clock64(); } } } while (0)
#define SYNC(c) do { xcd_barrier((unsigned*)WSP(WS_BAR), (volatile LAS unsigned*)(lds + PTAB_OFF + 384)); if (PROBE_CLASS) { const unsigned long long _n = wall_clock64(); if (PROBE_CLASS == (c)) tacc += _n - pt0; pt0 = _n; if (PROBE_CLASS == 10) { const unsigned long long _c = clock64(); if ((c) == 1) cycacc += _c - cyc0; cyc0 = _c; } } } while (0)
enum { I_X = 0, I_C, I_CTX, I_CCTX, I_N1G, I_N2G, I_MODW, I_MODB, I_FUP, I_FCW, I_FCB, I_FDN, I_CMIN, I_CMBIN, I_CMVG, I_CMVB, I_CMWS, I_CMBS, I_CMOUT,
       I_LIN, I_LCW, I_LCB, I_LWRG, I_LBRG, I_LWIG, I_LBIG, I_LLAM, I_LOUT, I_MIN, I_MBG, I_MNG, I_MOUT, I_FNG, I_OUT, I_WS };
__device__ __forceinline__ unsigned char* getp(LAS unsigned char* lds, int idx) {
    unsigned a = PTAB_OFF; asm volatile("" : "+v"(a));
    volatile LAS unsigned* t = (volatile LAS unsigned*)(lds + a);
    unsigned lo = t[2 * idx], hi = t[2 * idx + 1];
    lo = __builtin_amdgcn_readfirstlane(lo); hi = __builtin_amdgcn_readfirstlane(hi);
    return (unsigned char*)(((unsigned long long)hi << 32) | (unsigned long long)lo);
}
#define GF(i) ((const float*)getp(lds, (i)))
#define WSP(off) (getp(lds, I_WS) + (off))

__global__ void __launch_bounds__(512, 2) mega_fwd(Params P) {
    extern __shared__ __attribute__((aligned(16))) unsigned char shm[];
    LAS unsigned char* lds = (LAS unsigned char*)shm;
    cg::grid_group grid = cg::this_grid();
    if (threadIdx.x < 35) { const unsigned long long v = ((const unsigned long long*)&P)[threadIdx.x]; LAS unsigned* t = (LAS unsigned*)(lds + PTAB_OFF); t[2 * threadIdx.x] = (unsigned)v; t[2 * threadIdx.x + 1] = (unsigned)(v >> 32); }
    if (threadIdx.x == 0) { LAS unsigned* stw = (LAS unsigned*)(lds + PTAB_OFF + 384); stw[0] = 0u; stw[1] = 0u; stw[2] = 0u; stw[3] = 0u; }
    BLOCK_SYNC();
    if (threadIdx.x == 0) (void)xb_add(&((unsigned*)P.ws + WS_BAR / 4)[XB_XCNT(xb_xcc_id())], 1u);
    unsigned long long tacc = 0, pt0 = PROBE_CLASS ? wall_clock64() : 0ull, nkt = 0, cyc0 = 0, cycacc = 0;
    phase_prologue(lds, P);
    SYNC0(7);
    {
        float* SHW = (float*)WSP(WS_SHW); const float* MOD = (const float*)WSP(WS_MOD);
        shw_table(lds, MOD + (size_t)0 * 17 * 6144, 0, (const u16*)WSP(WS_CM_IN_T), 4096, SHW + SHW_IN_OFF0);
        shw_table(lds, MOD + (size_t)1 * 17 * 6144, 0, (const u16*)WSP(WS_LRU_IN_T), 2048, SHW + SHW_IN_OFF1);
        shw_table(lds, MOD + (size_t)2 * 17 * 6144, 0, (const u16*)WSP(WS_ML_IN_T), 3328, SHW + SHW_IN_OFF2);
        shw_table(lds, MOD + (size_t)3 * 17 * 6144, 0, (const u16*)WSP(WS_CM_IN_T) + (size_t)4096 * 1024, 4096, SHW + SHW_IN_OFF3);
#pragma unroll 1
        for (int l = 0; l < 4; ++l) shw_table(lds, MOD + (size_t)l * 17 * 6144, 3072, (const u16*)WSP(WS_FFN_UP_T + l * SZ_FFN_UP_T), F2, SHW + SHW_UP_OFF + (size_t)l * 17 * F2);
        phase_pre0(GF(I_X), GF(I_CTX), GF(I_N1G), MOD, 1024, (u16*)WSP(WS_ACT), (float*)WSP(WS_RS), MT);
    }
    SYNC(3);

#pragma unroll 1
    for (int l = 0; l < 4; ++l) {
        const int kind = l % 3, j = l / 3; const bool last = (l == 3);
        const int nM = last ? 256 : 272, nrows = last ? ML : MT;
        g8::Desc dout{};
        if (kind == 0) {
            { g8::Desc d{}; d.A = (const u16*)WSP(WS_ACT); d.Bt = (const u16*)WSP(WS_CM_IN_T) + (size_t)j * 4096 * 1024; d.lda = 1024; d.ldb = 1024; d.K = 1024; d.nM = nM; d.nN = 16; d.nZ = 1; d.ablk = 1;
              Epi<M_CMIN> E{}; E.p.o0 = (u16*)WSP(WS_ACT + SLOT); E.p.o1 = (u16*)WSP(WS_ACT + 3 * SLOT); E.p.f0 = (float*)WSP(WS_ACT + 6 * SLOT); E.p.bias = GF(I_CMBIN) + j * 4096; E.p.rsr = (const float*)WSP(WS_RS); E.p.shw = (const float*)WSP(WS_SHW) + (l == 0 ? SHW_IN_OFF0 : SHW_IN_OFF3); E.p.shwld = 4096;
              g8::gemm_phase(lds, d, E, tacc, nkt); }
            SYNC(1);
            phase_cm_spatial(lds, (u16*)WSP(WS_ACT + SLOT), (const u16*)WSP(WS_ACT + 3 * SLOT), (const float*)WSP(WS_ACT + 6 * SLOT), GF(I_CMWS) + (size_t)j * 8 * 128 * 128, GF(I_CMBS) + j * 8 * 128,
                             GF(I_CMVG) + j * 2048, GF(I_CMVB) + j * 2048, nrows / 128);
            SYNC(4);
            dout.A = (const u16*)WSP(WS_ACT + SLOT); dout.Bt = (const u16*)WSP(WS_CM_OUT_T) + (size_t)j * 1024 * 2048; dout.lda = 2048; dout.ldb = 2048; dout.K = 2048;
        } else if (kind == 1) {
            { g8::Desc d{}; d.A = (const u16*)WSP(WS_ACT); d.Bt = (const u16*)WSP(WS_LRU_IN_T); d.lda = 1024; d.ldb = 1024; d.K = 1024; d.nM = nM; d.nN = 8; d.nZ = 1; d.ablk = 1;
              Epi<M_LRUIN> E{}; E.p.o0 = (u16*)WSP(WS_ACT + SLOT); E.p.o1 = (u16*)WSP(WS_ACT + 2 * SLOT); E.p.rsr = (const float*)WSP(WS_RS); E.p.shw = (const float*)WSP(WS_SHW) + SHW_IN_OFF1; E.p.shwld = 2048;
              g8::gemm_phase(lds, d, E, tacc, nkt); }
            SYNC(1);
            phase_lru_conv((const u16*)WSP(WS_ACT + 2 * SLOT), GF(I_LCW), GF(I_LCB), (u16*)WSP(WS_ACT + 3 * SLOT));
            SYNC(3);
            { g8::Desc d{}; d.A = (const u16*)WSP(WS_ACT + 3 * SLOT); d.Bt = (const u16*)WSP(WS_LRU_G_T); d.lda = 1024; d.ldb = 256; d.K = 256; d.nM = nM; d.nN = 4; d.nZ = 4; d.zA = 256; d.zB = (size_t)1024 * 256;
              Epi<M_LRUG> E{}; E.p.o0 = (u16*)WSP(WS_ACT); E.p.o1 = (u16*)WSP(WS_ACT + 2 * SLOT);
              E.p.q0 = GF(I_LBRG); E.p.q1 = GF(I_LBIG); E.p.q2 = (const float*)WSP(WS_SP8); E.p.bsrc = (const u16*)WSP(WS_ACT + 3 * SLOT);
              g8::gemm_phase(lds, d, E, tacc, nkt); }
            SYNC(1);
            phase_lru_scanA((const u16*)WSP(WS_ACT), (const u16*)WSP(WS_ACT + 2 * SLOT), (const u16*)WSP(WS_ACT + 4 * SLOT), (const u16*)WSP(WS_ACT + 5 * SLOT), (float*)WSP(WS_SEG));
            SYNC(6);
            phase_lru_scanC((const u16*)WSP(WS_ACT), (u16*)WSP(WS_ACT + 2 * SLOT), (const u16*)WSP(WS_ACT + 4 * SLOT), (const u16*)WSP(WS_ACT + 5 * SLOT), (const float*)WSP(WS_SEG),
                            (const u16*)WSP(WS_ACT + SLOT), (u16*)WSP(WS_ACT + 3 * SLOT));
            SYNC(6);
            dout.A = (const u16*)WSP(WS_ACT + 3 * SLOT); dout.Bt = (const u16*)WSP(WS_LRU_OUT_T); dout.lda = 1024; dout.ldb = 1024; dout.K = 1024;
        } else {
            { g8::Desc d{}; d.A = (const u16*)WSP(WS_ACT); d.Bt = (const u16*)WSP(WS_ML_IN_T); d.lda = 1024; d.ldb = 1024; d.K = 1024; d.nM = nM; d.nN = 13; d.nZ = 1; d.ablk = 1;
              Epi<M_MLIN> E{}; E.p.o0 = (u16*)WSP(WS_ACT + SLOT); E.p.o1 = (u16*)WSP(WS_ACT + SLOT) + (size_t)MT * 512; E.p.o2 = (u16*)WSP(WS_ACT + 2 * SLOT); E.p.o3 = (u16*)WSP(WS_ACT + 3 * SLOT);
              E.p.f0 = (float*)WSP(WS_ACT + 6 * SLOT); E.p.bias = GF(I_MBG); E.p.rsr = (const float*)WSP(WS_RS); E.p.shw = (const float*)WSP(WS_SHW) + SHW_IN_OFF2; E.p.shwld = 3328;
              g8::gemm_phase(lds, d, E, tacc, nkt); }
            SYNC(1);
            phase_mlstm(lds, (const u16*)WSP(WS_ACT + SLOT), (const u16*)WSP(WS_ACT + SLOT) + (size_t)MT * 512, (const u16*)WSP(WS_ACT + 2 * SLOT), (const float*)WSP(WS_ACT + 6 * SLOT),
                        (u16*)WSP(WS_ACT + 4 * SLOT), (u16*)WSP(WS_ACT + 5 * SLOT));
            SYNC(5);
            phase_ml_readout((const u16*)WSP(WS_ACT + 4 * SLOT), (const u16*)WSP(WS_ACT + 5 * SLOT), (const u16*)WSP(WS_ACT + 3 * SLOT), GF(I_MNG), (u16*)WSP(WS_ACT + 3 * SLOT));
            SYNC(3);
            dout.A = (const u16*)WSP(WS_ACT + 3 * SLOT); dout.Bt = (const u16*)WSP(WS_ML_OUT_T); dout.lda = 1024; dout.ldb = 1024; dout.K = 1024;
        }
        { dout.nM = nM; dout.nN = 4; dout.nZ = 1;
          Epi<M_RES> E{}; E.p.xsl = (l == 0) ? GF(I_X) : GF(I_OUT); E.p.xsc = (l == 0) ? GF(I_CTX) : (const float*)WSP(WS_XC); E.p.xdl = (float*)getp(lds, I_OUT); E.p.xdc = (float*)WSP(WS_XC);
          E.p.gate = (const float*)WSP(WS_MOD) + (size_t)l * 17 * 6144 + 2048;
          E.p.ng = GF(I_N2G) + l * 1024; E.p.nsc = (const float*)WSP(WS_MOD) + (size_t)l * 17 * 6144 + 4096; E.p.xb = (u16*)WSP(WS_ACT); E.p.rs = (float*)WSP(WS_RS);
          g8::gemm_phase(lds, dout, E, tacc, nkt); }
        SYNC(1);
#pragma unroll 1
        for (int part = 0; part < 2; ++part) {
            const int pn0 = part ? 11 : 0, nt = part ? 10 : 11;
            { g8::Desc d{}; d.A = (const u16*)WSP(WS_ACT); d.Bt = (const u16*)WSP(WS_FFN_UP_T + l * SZ_FFN_UP_T); d.lda = 1024; d.ldb = 1024; d.K = 1024; d.nM = nM; d.nN = nt; d.nZ = 1; d.pn0 = pn0; d.ablk = 1;
              Epi<M_BF16> E{}; E.p.o0 = (u16*)WSP(WS_ACT + SLOT); E.p.ldc = nt * 256; E.p.pn0 = pn0; E.p.rsr = (const float*)WSP(WS_RS); E.p.shw = (const float*)WSP(WS_SHW) + SHW_UP_OFF + (size_t)l * 17 * F2; E.p.shwld = F2;
              g8::gemm_phase(lds, d, E, tacc, nkt); }
            SYNC(1);
            phase_ffn_conv(lds, (const u16*)WSP(WS_ACT + SLOT), nt, pn0, GF(I_FCW) + (size_t)l * 9 * F2, GF(I_FCB) + (size_t)l * F2, (u16*)WSP(WS_ACT + SLOT + (size_t)MT * 2816 * 2), !last, tacc);
            SYNC(2);
        }
        { g8::Desc d{}; d.A = (const u16*)WSP(WS_ACT + SLOT + (size_t)MT * 2816 * 2); d.Bt = (const u16*)WSP(WS_FFN_DN_T + l * SZ_FFN_DN_T); d.lda = FH; d.ldb = FH; d.K = FH; d.nM = nM; d.nN = 4; d.nZ = 1;
          Epi<M_RES> E{}; E.p.xsl = GF(I_OUT); E.p.xsc = (const float*)WSP(WS_XC); E.p.xdl = (float*)getp(lds, I_OUT); E.p.xdc = (float*)WSP(WS_XC);
          E.p.gate = (const float*)WSP(WS_MOD) + (size_t)l * 17 * 6144 + 5120;
          if (!last) { E.p.ng = GF(I_N1G) + (l + 1) * 1024; E.p.nsc = (const float*)WSP(WS_MOD) + (size_t)(l + 1) * 17 * 6144 + 1024; E.p.xb = (u16*)WSP(WS_ACT); E.p.rs = (float*)WSP(WS_RS); }
          g8::gemm_phase(lds, d, E, tacc, nkt); }
        SYNC(1);
    }
    phase_final_norm((float*)getp(lds, I_OUT), GF(I_FNG));
    if (PROBE_CLASS == 17) { for (int i = 0; i < 100; ++i) grid.sync(); tacc = 0; }
    if (PROBE_CLASS == 9 || PROBE_CLASS == 11 || PROBE_CLASS == 12) tacc = nkt ? (tacc * 100ull) / nkt : 0ull;
    if (PROBE_CLASS == 10) tacc = cycacc / 20ull;
    if (PROBE_CLASS) { const unsigned long long tend = wall_clock64() + tacc; while (wall_clock64() < tend) __builtin_amdgcn_s_sleep(16); }
}

extern "C" void kernel_launch(void* const* d_in, const int* in_sizes, int n_in, void* d_out, int out_size, void* d_ws, size_t ws_size, hipStream_t stream) {
    static int grid = 0;
    if (grid == 0) {
        if (n_in != 33 || ws_size < WS_END) { fprintf(stderr, "kernel_launch: unexpected n_in %d or ws_size %zu (< %zu)\n", n_in, ws_size, (size_t)WS_END); grid = -1; return; }
        int dev = 0, cus = 0, per_cu = 0;
        hipGetDevice(&dev); hipDeviceGetAttribute(&cus, hipDeviceAttributeMultiprocessorCount, dev);
        if (hipFuncSetAttribute((const void*)mega_fwd, hipFuncAttributeMaxDynamicSharedMemorySize, LDS_BYTES) != hipSuccess) { fprintf(stderr, "kernel_launch: hipFuncSetAttribute failed\n"); grid = -1; return; }
        hipOccupancyMaxActiveBlocksPerMultiprocessor(&per_cu, (const void*)mega_fwd, 512, LDS_BYTES);
        (void)hipGetLastError();
        if (per_cu < 1) per_cu = 1;
        grid = cus * 1;
    }
    if (grid < 0) return;
    Params p{};
    const float** pp = (const float**)&p;
    for (int i = 0; i < 33; ++i) pp[i] = (const float*)d_in[i];
    p.out = (float*)d_out; p.ws = (unsigned char*)d_ws;
    (void)hipMemsetAsync((unsigned char*)d_ws + WS_BAR, 0, 16384, stream);
    void* args[] = {&p};
    hipError_t e = hipLaunchCooperativeKernel((const void*)mega_fwd, dim3(grid), dim3(512), args, LDS_BYTES, stream);
    if (e != hipSuccess) fprintf(stderr, "cooperative launch failed: %s (grid %d)\n", hipGetErrorString(e), grid);
}
```

```cpp
#include <hip/hip_runtime.h>
#include <hip/hip_cooperative_groups.h>
#include <cstdio>
namespace cg = cooperative_groups;

#define LAS __attribute__((address_space(3)))
typedef unsigned short u16;
typedef short bf16x8 __attribute__((ext_vector_type(8)));
typedef float f32x4 __attribute__((ext_vector_type(4)));
typedef float f32x2 __attribute__((ext_vector_type(2)));
typedef unsigned u32x4 __attribute__((ext_vector_type(4)));
typedef unsigned u32x2 __attribute__((ext_vector_type(2)));

constexpr int DM = 1024, NB = 16, SEQ = 4096, CTXL = 256;
constexpr int ML = NB * SEQ, MC = NB * CTXL, MT = ML + MC;
constexpr int FH = 2688, F2 = 5376;
constexpr int LDS_BYTES = 147456;
#ifndef PROBE_CLASS
#define PROBE_CLASS 0
#endif
#define XCD_REMAP 1

constexpr size_t SZ_FFN_UP_T = (size_t)F2 * 1024 * 2, SZ_FFN_DN_T = (size_t)1024 * FH * 2;
constexpr size_t WS_FFN_UP_T = 0;
constexpr size_t WS_FFN_DN_T = WS_FFN_UP_T + 4 * SZ_FFN_UP_T;
constexpr size_t WS_CM_IN_T = WS_FFN_DN_T + 4 * SZ_FFN_DN_T;
constexpr size_t WS_CM_OUT_T = WS_CM_IN_T + 2 * (size_t)4096 * 1024 * 2;
constexpr size_t WS_LRU_IN_T = WS_CM_OUT_T + 2 * (size_t)1024 * 2048 * 2;
constexpr size_t WS_LRU_G_T = WS_LRU_IN_T + (size_t)2048 * 1024 * 2;
constexpr size_t WS_LRU_OUT_T = WS_LRU_G_T + (size_t)4 * 1024 * 256 * 2;
constexpr size_t WS_ML_IN_T = WS_LRU_OUT_T + (size_t)1024 * 1024 * 2;
constexpr size_t WS_ML_OUT_T = WS_ML_IN_T + (size_t)3328 * 1024 * 2;
constexpr size_t WS_XC = WS_ML_OUT_T + (size_t)1024 * 1024 * 2;
constexpr size_t WS_MOD = WS_XC + (size_t)MC * 1024 * 4;
constexpr size_t WS_SEG = WS_MOD + (size_t)4 * 17 * 6144 * 4;
constexpr size_t WS_SP8 = WS_SEG + (size_t)2 * 544 * 1024 * 2 * 4;
constexpr size_t WS_RS = WS_SP8 + 8192;
constexpr size_t WS_SHW = WS_RS + (size_t)MT * 16 * 4;
constexpr int SHW_IN_OFF0 = 0, SHW_IN_OFF1 = 17 * 4096, SHW_IN_OFF2 = SHW_IN_OFF1 + 17 * 2048, SHW_IN_OFF3 = SHW_IN_OFF2 + 17 * 3328, SHW_UP_OFF = SHW_IN_OFF3 + 17 * 4096;
constexpr size_t WS_BAR = WS_SHW + (size_t)(SHW_UP_OFF + 4 * 17 * F2) * 4;
constexpr size_t WS_ACT = WS_BAR + 16384;
constexpr size_t SLOT = (size_t)MT * 1024 * 2;
constexpr size_t WS_END = WS_ACT + SLOT + (size_t)MT * 2816 * 2 + (size_t)MT * FH * 2;

struct Params {
    const float *x, *c, *ctx, *c_ctx, *norm1_g, *norm2_g, *mod_w, *mod_b, *ffn_w_up, *ffn_conv_w, *ffn_conv_b, *ffn_w_down,
        *cm_w_in, *cm_b_in, *cm_v_g, *cm_v_b, *cm_w_s, *cm_b_s, *cm_w_out, *lru_w_in, *lru_conv_w, *lru_conv_b, *lru_w_rg, *lru_b_rg,
        *lru_w_ig, *lru_b_ig, *lru_lambda, *lru_w_out, *ml_w_in, *ml_b_gate, *ml_norm_g, *ml_w_out, *final_norm_g;
    float* out; unsigned char* ws;
};

__device__ __forceinline__ unsigned cvt_pk_bf16(float lo, float hi) { unsigned r; asm volatile("v_cvt_pk_bf16_f32 %0, %1, %2" : "=v"(r) : "v"(lo), "v"(hi)); return r; }
__device__ __forceinline__ float bf_lo(unsigned w) { return __uint_as_float(w << 16); }
__device__ __forceinline__ float bf_hi(unsigned w) { return __uint_as_float(w & 0xffff0000u); }
__device__ __forceinline__ float bf2f(u16 b) { return __uint_as_float(((unsigned)b) << 16); }
__device__ __forceinline__ u16 f2bf(float f) { return (u16)(cvt_pk_bf16(f, 0.f) & 0xffffu); }
__device__ __forceinline__ float wave_sum(float v) {
#pragma unroll
    for (int o = 1; o < 64; o <<= 1) v += __shfl_xor(v, o);
    return v;
}
__device__ __forceinline__ float fexp_(float x) { return __builtin_amdgcn_exp2f(x * 1.4426950408889634f); }
__device__ __forceinline__ float sigmoidf_(float x) { return __builtin_amdgcn_rcpf(1.0f + fexp_(-x)); }
__device__ __forceinline__ float gelu_tanh(float x) { const float t = x * (1.5957691216f + 0.0713548163f * x * x); return x * __builtin_amdgcn_rcpf(1.0f + fexp_(-t)); }
__device__ __forceinline__ float siluf_(float x) { return x * __builtin_amdgcn_rcpf(1.0f + fexp_(-x)); }
__device__ __forceinline__ void unpack8(const u32x4 w, float (&f)[8]) {
    f[0] = bf_lo(w.x); f[1] = bf_hi(w.x); f[2] = bf_lo(w.y); f[3] = bf_hi(w.y); f[4] = bf_lo(w.z); f[5] = bf_hi(w.z); f[6] = bf_lo(w.w); f[7] = bf_hi(w.w);
}
__device__ __forceinline__ u32x4 pack8(const float (&f)[8]) {
    u32x4 w; w.x = cvt_pk_bf16(f[0], f[1]); w.y = cvt_pk_bf16(f[2], f[3]); w.z = cvt_pk_bf16(f[4], f[5]); w.w = cvt_pk_bf16(f[6], f[7]); return w;
}
typedef _Float16 h2_t __attribute__((ext_vector_type(2)));
struct h2x4 { h2_t v[4]; };
__device__ __forceinline__ unsigned cvt_pk_f16(float lo, float hi) { return __builtin_bit_cast(unsigned, __builtin_amdgcn_cvt_pkrtz(lo, hi)); }
__device__ __forceinline__ void unpack8h(const u32x4 w, float (&f)[8]) {
    const h2x4 h = __builtin_bit_cast(h2x4, w);
#pragma unroll
    for (int q = 0; q < 4; ++q) { f[2 * q] = (float)h.v[q].x; f[2 * q + 1] = (float)h.v[q].y; }
}
#define BLOCK_SYNC() __syncthreads()
__device__ __forceinline__ size_t ablk(int row, int col, int KT) { return ((((size_t)(row >> 8) * KT + (col >> 6)) * 256 + (row & 255)) << 6) + (col & 63); }
__device__ __forceinline__ int obid() { int t = blockIdx.x; asm volatile("" : "+s"(t)); return t; }
__device__ __forceinline__ int ogdim() { int t = gridDim.x; asm volatile("" : "+s"(t)); return t; }
__device__ __forceinline__ int opaque_tid() { int t = threadIdx.x; asm volatile("" : "+v"(t)); return t; }

namespace g8 {
constexpr int BM = 256, BK = 64, HALF = 128, HTB = HALF * BK * 2, STAGE_BYTES = 8 * HTB, NXCD = 8, WGM = 4;
__device__ __forceinline__ int lds_byte(int r, int c) { const int st = (r >> 4) * 2 + (c >> 5), rr = r & 15, cc = c & 31, ob = rr * 64 + cc * 2; return st * 1024 + (ob ^ (((ob >> 9) & 1) << 5)); }
__device__ __forceinline__ void stage_rc(int b, int& R, int& C) { const int st = b / 1024, sb = b % 1024, swz = sb ^ (((sb >> 9) & 1) << 5); R = (st >> 1) * 16 + swz / 64; C = (st & 1) * 32 + (swz % 64) / 2; }
__device__ __forceinline__ int perm32(int rho) { const int n = rho >> 4, i = rho & 15; return 8 * (i >> 2) + 4 * n + (i & 3); }

struct Unit { int pm, pn, z; };
struct Desc { const u16* A; const u16* Bt; int lda, ldb, K, nM, nN, nZ, pm0, pn0; size_t zA, zB; int ablk; };

__device__ __forceinline__ bool next_unit(const Desc& g, int i, Unit& u) {
    const int nwg = g.nM * g.nN; const long L = (long)i * ogdim() + obid(); if (L >= (long)nwg * g.nZ) return false;
    u.z = (int)(L / nwg); int wgid = (int)(L % nwg);
#if XCD_REMAP
    { const int q = nwg / NXCD, r = nwg % NXCD, xcd = wgid % NXCD, off = wgid / NXCD; wgid = (xcd < r ? xcd * (q + 1) : r * (q + 1) + (xcd - r) * q) + off; }
#endif
    const int nig = WGM * g.nN, gid = wgid / nig, fm = gid * WGM, gsz = (g.nM - fm) < WGM ? (g.nM - fm) : WGM;
    u.pm = g.pm0 + fm + ((wgid % nig) % gsz); u.pn = g.pn0 + (wgid % nig) / gsz; return true;
}

template <class Epi>
__device__ __forceinline__ void gemm_phase(LAS unsigned char* lds, const Desc g, const Epi& E, unsigned long long& tepi, unsigned long long& g_ktiles) {
    const int tid = opaque_tid(), wid = __builtin_amdgcn_readfirstlane(tid >> 6), lane = tid & 63, wr = wid >> 2, wc = wid & 3, fr = lane & 15, fq = lane >> 4;
    const int K = g.K, nt = K / BK;
    unsigned voffA[2], voffB[2];
#pragma unroll
    for (int i = 0; i < 2; ++i) { int R, C; stage_rc(tid * 16 + i * 8192, R, C); const int Rb = Epi::PERM ? ((R & ~31) + perm32(R & 31)) : R;
        voffA[i] = g.ablk ? (unsigned)(R * 64 + C) * 2u : (unsigned)(R * g.lda + C) * 2u; voffB[i] = (unsigned)(Rb * g.ldb + C) * 2u; }
    const size_t kstepB = (size_t)(BK * 2), kstepA = g.ablk ? (size_t)(256 * BK * 2) : (size_t)(BK * 2);
    const size_t hstepA = g.ablk ? (size_t)(HALF * BK * 2) : (size_t)HALF * g.lda * 2, hstepB = (size_t)HALF * g.ldb * 2;
    const size_t tstepA = (size_t)256 * g.lda * 2, tstepB = 2 * hstepB;
    const unsigned ldsw = (unsigned)wid * 1024u;
    const int aoff = lds_byte(wr * 64 + fr, fq * 8), boff = lds_byte(wc * 32 + fr, fq * 8);
#define PG8_SA(b, h) (((b) * 2 + (h)) * HTB)
#define PG8_SB(b, h) ((4 + (b) * 2 + (h)) * HTB)
#define PG8_STAGE(bufoff, gbase, voff) do { _Pragma("unroll") for (int _i = 0; _i < 2; ++_i) \
        __builtin_amdgcn_global_load_lds((const unsigned*)((const char*)(gbase) + (voff)[_i]), (LAS unsigned*)(lds + (bufoff) + ldsw + _i * 8192), 16, 0, 0); } while (0)
#define PG8_LDA(dst, b, h) do { _Pragma("unroll") for (int m = 0; m < 4; ++m) _Pragma("unroll") for (int k = 0; k < 2; ++k) dst[m][k] = *(const LAS bf16x8*)(lds + PG8_SA(b, h) + aoff + m * 2048 + k * 1024); } while (0)
#define PG8_LDB(dst, b, h) do { _Pragma("unroll") for (int n = 0; n < 2; ++n) _Pragma("unroll") for (int k = 0; k < 2; ++k) dst[n][k] = *(const LAS bf16x8*)(lds + PG8_SB(b, h) + boff + n * 2048 + k * 1024); } while (0)
#define PG8_MMA(ai, bj, At, Bt) do { __builtin_amdgcn_s_setprio(1); _Pragma("unroll") for (int m = 0; m < 4; ++m) _Pragma("unroll") for (int n = 0; n < 2; ++n) _Pragma("unroll") for (int k = 0; k < 2; ++k) \
        acc[ai][bj][m][n] = __builtin_amdgcn_mfma_f32_16x16x32_bf16(Bt[n][k], At[m][k], acc[ai][bj][m][n], 0, 0, 0); __builtin_amdgcn_s_setprio(0); } while (0)
#define PG8_WAIT_V(n) asm volatile("s_waitcnt vmcnt(" #n ")" ::: "memory")
#define PG8_WAIT_L(n) asm volatile("s_waitcnt lgkmcnt(" #n ")" ::: "memory")
#define PG8_BAR __builtin_amdgcn_s_barrier()
#define PG8_SCHED __builtin_amdgcn_sched_barrier(0)
    Unit cur, nxt; int ui = 0;
    if (!next_unit(g, 0, cur)) return;
    f32x4 acc[2][2][4][2];
#pragma unroll
    for (int a = 0; a < 2; ++a)
#pragma unroll
        for (int b = 0; b < 2; ++b)
#pragma unroll
            for (int m = 0; m < 4; ++m)
#pragma unroll
                for (int n = 0; n < 2; ++n) acc[a][b][m][n] = (f32x4){0.f, 0.f, 0.f, 0.f};
    bf16x8 At[4][2], B0[2][2], B1[2][2];
    const char* cA = (const char*)g.A + ((size_t)cur.z * g.zA) * 2 + (size_t)cur.pm * tstepA;
    const char* cB = (const char*)g.Bt + ((size_t)cur.z * g.zB) * 2 + (size_t)cur.pn * tstepB;
    PG8_STAGE(PG8_SB(0, 0), cB, voffB); PG8_STAGE(PG8_SB(0, 1), cB + hstepB, voffB); PG8_STAGE(PG8_SA(0, 0), cA, voffA); PG8_STAGE(PG8_SA(0, 1), cA + hstepA, voffA);
    if (wr == 1) PG8_BAR;
    PG8_WAIT_V(2); PG8_BAR;
    PG8_STAGE(PG8_SB(1, 0), cB + kstepB, voffB); PG8_STAGE(PG8_SA(1, 0), cA + kstepA, voffA); PG8_STAGE(PG8_SB(1, 1), cB + hstepB + kstepB, voffB);
    PG8_WAIT_V(6); PG8_BAR;
    for (;;) {
        const bool has_next = next_unit(g, ui + 1, nxt);
        const char* nA = has_next ? (const char*)g.A + ((size_t)nxt.z * g.zA) * 2 + (size_t)nxt.pm * tstepA : cA;
        const char* nB = has_next ? (const char*)g.Bt + ((size_t)nxt.z * g.zB) * 2 + (size_t)nxt.pn * tstepB : cB;
        unsigned long long kc0 = 0; if (PROBE_CLASS == 9 || PROBE_CLASS == 11 || PROBE_CLASS == 12) kc0 = clock64();
        for (int t = 0; t < nt; t += 2) {
            const bool last = (t == nt - 2);
            const char* a1 = cA + (size_t)(t + 1) * kstepA;
            const char* a2 = last ? nA : cA + (size_t)(t + 2) * kstepA; const char* b2 = last ? nB : cB + (size_t)(t + 2) * kstepB;
            const char* a3 = a2 + kstepA; const char* b3 = b2 + kstepB;
            PG8_LDB(B0, 0, 0); PG8_LDB(B1, 0, 1); PG8_SCHED; PG8_LDA(At, 0, 0); PG8_STAGE(PG8_SA(1, 1), a1 + hstepA, voffA);
            PG8_WAIT_V(8); PG8_WAIT_L(0); PG8_BAR; PG8_MMA(0, 0, At, B0); PG8_MMA(0, 1, At, B1); PG8_BAR; PG8_SCHED;
            PG8_LDA(At, 0, 1); PG8_STAGE(PG8_SB(0, 0), b2, voffB); PG8_STAGE(PG8_SB(0, 1), b2 + hstepB, voffB); PG8_STAGE(PG8_SA(0, 0), a2, voffA);
            PG8_WAIT_V(8); PG8_WAIT_L(0); PG8_BAR; PG8_MMA(1, 0, At, B0); PG8_MMA(1, 1, At, B1); PG8_BAR; PG8_SCHED;
            PG8_LDB(B0, 1, 0); PG8_LDB(B1, 1, 1); PG8_SCHED; PG8_LDA(At, 1, 0); PG8_STAGE(PG8_SA(0, 1), a2 + hstepA, voffA);
            PG8_WAIT_V(8); PG8_WAIT_L(0); PG8_BAR; PG8_MMA(0, 0, At, B0); PG8_MMA(0, 1, At, B1); PG8_BAR; PG8_SCHED;
            PG8_LDA(At, 1, 1); PG8_STAGE(PG8_SB(1, 0), b3, voffB); PG8_STAGE(PG8_SB(1, 1), b3 + hstepB, voffB); PG8_STAGE(PG8_SA(1, 0), a3, voffA);
            PG8_WAIT_V(8); PG8_WAIT_L(0); PG8_BAR; PG8_MMA(1, 0, At, B0); PG8_MMA(1, 1, At, B1); PG8_BAR; PG8_SCHED;
        }
        if (PROBE_CLASS == 9 || (PROBE_CLASS == 11 && ui == 0) || (PROBE_CLASS == 12 && ui >= 3)) { tepi += (clock64() - kc0); g_ktiles += nt; }
        if (wr == 0) PG8_BAR;
        if (PROBE_CLASS == 8) { const unsigned long long e0 = wall_clock64(); E(acc, cur, wr, wc, fr, fq); asm volatile("s_waitcnt vmcnt(0)" ::: "memory"); tepi += wall_clock64() - e0; } else E(acc, cur, wr, wc, fr, fq);
        if (!has_next) break;
#pragma unroll
        for (int a = 0; a < 2; ++a)
#pragma unroll
            for (int b = 0; b < 2; ++b)
#pragma unroll
                for (int m = 0; m < 4; ++m)
#pragma unroll
                    for (int n = 0; n < 2; ++n) acc[a][b][m][n] = (f32x4){0.f, 0.f, 0.f, 0.f};
        cur = nxt; cA = nA; cB = nB; ++ui;
        if (wr == 1) PG8_BAR;
    }
    PG8_WAIT_V(0);
    PG8_BAR;
#undef PG8_SA
#undef PG8_SB
#undef PG8_STAGE
#undef PG8_LDA
#undef PG8_LDB
#undef PG8_MMA
#undef PG8_WAIT_V
#undef PG8_WAIT_L
#undef PG8_BAR
#undef PG8_SCHED
}
}

__device__ __forceinline__ void rows_rstd(const float* rs, int row0, int fq, float (&rstd)[2][4]) {
    f32x4 pr[2][4];
#pragma unroll
    for (int ai = 0; ai < 2; ++ai)
#pragma unroll
        for (int m = 0; m < 4; ++m) pr[ai][m] = *(const f32x4*)(rs + (size_t)(row0 + ai * 128 + m * 16) * 16 + 4 * fq);
#pragma unroll
    for (int ai = 0; ai < 2; ++ai)
#pragma unroll
        for (int m = 0; m < 4; ++m) { float s = (pr[ai][m].x + pr[ai][m].y) + (pr[ai][m].z + pr[ai][m].w); s += __shfl_xor(s, 16); s += __shfl_xor(s, 32);
            rstd[ai][m] = __builtin_amdgcn_rsqf(s * (1.0f / 1024.0f) + 1e-6f); }
}
enum { M_BF16 = 0, M_CMIN = 1, M_RES = 2, M_LRUIN = 3, M_LRUG = 4, M_MLIN = 5 };
struct EP {
    u16 *o0, *o1, *o2, *o3; float* f0;
    const float *xsl, *xsc; float *xdl, *xdc;
    const float *gate, *bias, *q0, *q1, *q2; const u16* bsrc;
    int ldc, pn0;
    const float *ng, *nsc; u16* xb; float* rs;
    const float *rsr, *shw; int shwld;
};
template <int MODE> struct Epi {
    static constexpr bool PERM = (MODE != M_RES);
    EP p;
    __device__ __forceinline__ void operator()(const f32x4 (&acc)[2][2][4][2], const g8::Unit& u, int wr, int wc, int fr, int fq) const {
        const int row0 = u.pm * 256 + wr * 64 + fr;
        if constexpr (MODE == M_RES) {
            const int col0 = u.pn * 256 + wc * 32 + 4 * fq;
            const bool lat = u.pm < 256; const int mb = lat ? (u.pm >> 4) : 16;
            const float* gp = p.gate + (size_t)mb * 6144 + col0;
            const bool wxb = p.xb != nullptr;
            f32x4 gv[2][2], gm[2][2];
#pragma unroll
            for (int bj = 0; bj < 2; ++bj)
#pragma unroll
                for (int n = 0; n < 2; ++n) { gv[bj][n] = *(const f32x4*)(gp + bj * 128 + n * 16);
                    if (wxb) { const f32x4 g4 = *(const f32x4*)(p.ng + col0 + bj * 128 + n * 16), s4 = *(const f32x4*)(p.nsc + (size_t)mb * 6144 + col0 + bj * 128 + n * 16); gm[bj][n] = g4 * (s4 + 1.0f); }
                    else gm[bj][n] = (f32x4){0.f, 0.f, 0.f, 0.f}; }
            const float* xs = lat ? p.xsl : p.xsc; float* xd = lat ? p.xdl : p.xdc; const int rbase = lat ? row0 : row0 - ML;
#pragma unroll
            for (int ai2 = 0; ai2 < 4; ++ai2) { const int ai = ai2 >> 1, mb0 = (ai2 & 1) * 2;
                f32x4 xv[4][2][2];
#pragma unroll
                for (int m = mb0; m < mb0 + 2; ++m) { const size_t off = (size_t)(rbase + ai * 128 + m * 16) * 1024 + col0;
#pragma unroll
                    for (int bj = 0; bj < 2; ++bj)
#pragma unroll
                        for (int n = 0; n < 2; ++n) xv[m][bj][n] = *(const f32x4*)(xs + off + bj * 128 + n * 16); }
#pragma unroll
                for (int m = mb0; m < mb0 + 2; ++m) { const size_t off = (size_t)(rbase + ai * 128 + m * 16) * 1024 + col0; const int row = row0 + ai * 128 + m * 16; float ssq = 0.f;
#pragma unroll
                    for (int bj = 0; bj < 2; ++bj)
#pragma unroll
                        for (int n = 0; n < 2; ++n) { const f32x4 xn = xv[m][bj][n] + gv[bj][n] * acc[ai][bj][m][n];
                            *(f32x4*)(xd + off + bj * 128 + n * 16) = xn;
                            if (wxb) { ssq += (xn.x * xn.x + xn.y * xn.y) + (xn.z * xn.z + xn.w * xn.w); const f32x4 hb = xn * gm[bj][n];
                                u32x2 o; o.x = cvt_pk_bf16(hb.x, hb.y); o.y = cvt_pk_bf16(hb.z, hb.w); *(u32x2*)(p.xb + ablk(row, col0 + bj * 128 + n * 16, 16)) = o; } }
                    if (wxb) { ssq += __shfl_xor(ssq, 16); ssq += __shfl_xor(ssq, 32); if (fq == 0) p.rs[(size_t)row * 16 + u.pn * 4 + wc] = ssq; } }
            }
        } else if constexpr (MODE == M_BF16) {
            const int col0 = (u.pn - p.pn0) * 256 + wc * 32 + 8 * fq, colg = u.pn * 256 + wc * 32 + 8 * fq;
            const int mb = u.pm < 256 ? (u.pm >> 4) : 16;
            f32x4 sv[2][2];
#pragma unroll
            for (int bj = 0; bj < 2; ++bj)
#pragma unroll
                for (int n = 0; n < 2; ++n) sv[bj][n] = *(const f32x4*)(p.shw + (size_t)mb * p.shwld + colg + bj * 128 + 4 * n);
float rstd8[2][4]; rows_rstd(p.rsr, row0, fq, rstd8);
#pragma unroll
            for (int ai = 0; ai < 2; ++ai)
#pragma unroll
                for (int m = 0; m < 4; ++m) { const int row = row0 + ai * 128 + m * 16; const float rstd = rstd8[ai][m]; const int tjl = u.pn - p.pn0, cin = (wc & 1) * 32 + 8 * fq;
#pragma unroll
                    for (int bj = 0; bj < 2; ++bj) { const f32x4 v0 = acc[ai][bj][m][0] * rstd + sv[bj][0], v1 = acc[ai][bj][m][1] * rstd + sv[bj][1];
                        u32x4 w; w.x = cvt_pk_f16(v0[0], v0[1]); w.y = cvt_pk_f16(v0[2], v0[3]); w.z = cvt_pk_f16(v1[0], v1[1]); w.w = cvt_pk_f16(v1[2], v1[3]);
                        *(u32x4*)(p.o0 + (((size_t)(tjl * 4 + 2 * bj + (wc >> 1)) * MT + row) << 6) + cin) = w; } }
        } else if constexpr (MODE == M_CMIN) {
            const int colg = u.pn * 256 + wc * 32 + 8 * fq;
            const bool isv = u.pn >= 8; u16* base = isv ? p.o1 : p.o0; const int colt = colg - (isv ? 2048 : 0);
            f32x4 bv[2][2];
#pragma unroll
            for (int bj = 0; bj < 2; ++bj)
#pragma unroll
                for (int n = 0; n < 2; ++n) bv[bj][n] = *(const f32x4*)(p.bias + colg + bj * 128 + 4 * n) + *(const f32x4*)(p.shw + (size_t)(u.pm < 256 ? (u.pm >> 4) : 16) * p.shwld + colg + bj * 128 + 4 * n);
float rstd8[2][4]; rows_rstd(p.rsr, row0, fq, rstd8);
#pragma unroll
            for (int ai = 0; ai < 2; ++ai)
#pragma unroll
                for (int m = 0; m < 4; ++m) { const int row = row0 + ai * 128 + m * 16; const float rstd = rstd8[ai][m]; u16* rp = base + (size_t)row * 2048 + colt; float s = 0.f, ss = 0.f;
#pragma unroll
                    for (int bj = 0; bj < 2; ++bj) { f32x4 v0 = acc[ai][bj][m][0] * rstd + bv[bj][0], v1 = acc[ai][bj][m][1] * rstd + bv[bj][1];
#pragma unroll
                        for (int e = 0; e < 4; ++e) { v0[e] = gelu_tanh(v0[e]); v1[e] = gelu_tanh(v1[e]); s += v0[e] + v1[e]; ss += v0[e] * v0[e] + v1[e] * v1[e]; }
                        u32x4 w; w.x = cvt_pk_bf16(v0[0], v0[1]); w.y = cvt_pk_bf16(v0[2], v0[3]); w.z = cvt_pk_bf16(v1[0], v1[1]); w.w = cvt_pk_bf16(v1[2], v1[3]);
                        *(u32x4*)(rp + bj * 128) = w; }
                    if (isv) { s += __shfl_xor(s, 16); s += __shfl_xor(s, 32); ss += __shfl_xor(ss, 16); ss += __shfl_xor(ss, 32);
                        if (fq == 0) *(f32x2*)(p.f0 + ((size_t)row * 32 + (u.pn - 8) * 4 + wc) * 2) = (f32x2){s, ss}; } }
        } else if constexpr (MODE == M_LRUIN) {
            const int colg = u.pn * 256 + wc * 32 + 8 * fq;
            const bool isx = u.pn >= 4; u16* base = isx ? p.o1 : p.o0; const int colt = colg - (isx ? 1024 : 0);
            const int mb = u.pm < 256 ? (u.pm >> 4) : 16;
            f32x4 sv[2][2];
#pragma unroll
            for (int bj = 0; bj < 2; ++bj)
#pragma unroll
                for (int n = 0; n < 2; ++n) sv[bj][n] = *(const f32x4*)(p.shw + (size_t)mb * p.shwld + colg + bj * 128 + 4 * n);
float rstd8[2][4]; rows_rstd(p.rsr, row0, fq, rstd8);
#pragma unroll
            for (int ai = 0; ai < 2; ++ai)
#pragma unroll
                for (int m = 0; m < 4; ++m) { const int row = row0 + ai * 128 + m * 16; const float rstd = rstd8[ai][m]; u16* rp = base + (size_t)row * 1024 + colt;
#pragma unroll
                    for (int bj = 0; bj < 2; ++bj) { f32x4 v0 = acc[ai][bj][m][0] * rstd + sv[bj][0], v1 = acc[ai][bj][m][1] * rstd + sv[bj][1];
                        if (!isx) {
#pragma unroll
                            for (int e = 0; e < 4; ++e) { v0[e] = gelu_tanh(v0[e]); v1[e] = gelu_tanh(v1[e]); } }
                        u32x4 w; w.x = cvt_pk_bf16(v0[0], v0[1]); w.y = cvt_pk_bf16(v0[2], v0[3]); w.z = cvt_pk_bf16(v1[0], v1[1]); w.w = cvt_pk_bf16(v1[2], v1[3]);
                        *(u32x4*)(rp + bj * 128) = w; } }
        } else if constexpr (MODE == M_LRUG) {
            const int h = u.z, d = u.pn >> 1, jb = u.pn & 1;
            const int ch = h * 256 + jb * 128 + wc * 32 + 8 * fq;
            u16* la = p.o0 + (size_t)d * (4 * (SLOT / 2)); u16* bo = p.o1 + (size_t)d * (3 * (SLOT / 2));
#pragma unroll
            for (int n = 0; n < 2; ++n) {
                const int c4 = ch + 4 * n;
                const f32x4 brg = *(const f32x4*)(p.q0 + d * 1024 + c4), big = *(const f32x4*)(p.q1 + d * 1024 + c4), sp4 = *(const f32x4*)(p.q2 + d * 1024 + c4);
#pragma unroll
                for (int ai = 0; ai < 2; ++ai) {
                    u32x2 xr4[4];
#pragma unroll
                    for (int m = 0; m < 4; ++m) xr4[m] = *(const u32x2*)(p.bsrc + (size_t)(row0 + ai * 128 + m * 16) * 1024 + c4);
#pragma unroll
                    for (int m = 0; m < 4; ++m) { const size_t off = (size_t)(row0 + ai * 128 + m * 16) * 1024 + c4;
                        const u32x2 xr = xr4[m]; const float xv[4] = {bf_lo(xr.x), bf_hi(xr.x), bf_lo(xr.y), bf_hi(xr.y)};
                        float lo[4], bb[4];
#pragma unroll
                        for (int e = 0; e < 4; ++e) { const float r = sigmoidf_(acc[ai][0][m][n][e] + brg[e]), ig = sigmoidf_(acc[ai][1][m][n][e] + big[e]);
                            const float lg = -sp4[e] * r; lo[e] = lg; bb[e] = __builtin_amdgcn_sqrtf(fmaxf(1.0f - fexp_(2.0f * lg), 0.f)) * ig * xv[e]; }
                        u32x2 o1; o1.x = cvt_pk_bf16(lo[0], lo[1]); o1.y = cvt_pk_bf16(lo[2], lo[3]); *(u32x2*)(la + off) = o1;
                        u32x2 o2; o2.x = cvt_pk_bf16(bb[0], bb[1]); o2.y = cvt_pk_bf16(bb[2], bb[3]); *(u32x2*)(bo + off) = o2; }
                }
            }
        } else if constexpr (MODE == M_MLIN) {
            const int colg = u.pn * 256 + wc * 32 + 8 * fq;
            const int reg = u.pn < 2 ? 0 : (u.pn < 4 ? 1 : (u.pn < 8 ? 2 : (u.pn < 12 ? 3 : 4)));
            u16* base = reg == 0 ? p.o0 : (reg == 1 ? p.o1 : (reg == 2 ? p.o2 : p.o3));
            const int ld = (reg < 2) ? 512 : 1024; const int colt = colg - (reg == 0 ? 0 : (reg == 1 ? 512 : (reg == 2 ? 1024 : 2048)));
            const int mb = u.pm < 256 ? (u.pm >> 4) : 16;
            f32x4 sv[2][2];
#pragma unroll
            for (int bj = 0; bj < 2; ++bj)
#pragma unroll
                for (int n = 0; n < 2; ++n) sv[bj][n] = *(const f32x4*)(p.shw + (size_t)mb * p.shwld + colg + bj * 128 + 4 * n);
float rstd8[2][4]; rows_rstd(p.rsr, row0, fq, rstd8);
#pragma unroll
            for (int ai = 0; ai < 2; ++ai)
#pragma unroll
                for (int m = 0; m < 4; ++m) { const int row = row0 + ai * 128 + m * 16; const float rstd = rstd8[ai][m];
                    if (reg < 4) { u16* rp = base + (size_t)row * ld + colt;
#pragma unroll
                        for (int bj = 0; bj < 2; ++bj) { f32x4 v0 = acc[ai][bj][m][0] * rstd + sv[bj][0], v1 = acc[ai][bj][m][1] * rstd + sv[bj][1];
                            if (reg == 0) { v0 = v0 * 0.08838834764831845f; v1 = v1 * 0.08838834764831845f; }
                            if (reg == 3) {
#pragma unroll
                                for (int e = 0; e < 4; ++e) { v0[e] = sigmoidf_(v0[e]); v1[e] = sigmoidf_(v1[e]); } }
                            u32x4 w; w.x = cvt_pk_bf16(v0[0], v0[1]); w.y = cvt_pk_bf16(v0[2], v0[3]); w.z = cvt_pk_bf16(v1[0], v1[1]); w.w = cvt_pk_bf16(v1[2], v1[3]);
                            *(u32x4*)(rp + bj * 128) = w; }
                    } else {
                        const int cl = wc * 32 + 8 * fq;
                        if (cl < 16) {
#pragma unroll
                            for (int e = 0; e < 8; ++e) p.f0[(size_t)row * 16 + cl + e] = acc[ai][0][m][e >> 2][e & 3] * rstd + sv[0][e >> 2][e & 3] + p.bias[cl + e]; }
                    } }
        }
    }
};

__device__ __forceinline__ void tr_item(const float* src, int ld, int nvalid, u16* dst, int ldd, LAS float* scr, int lane) {
#pragma unroll
    for (int i = 0; i < 8; ++i) { const int kk = 8 * i + (lane >> 3), c4 = (lane & 7) * 4;
        const f32x4 v = (c4 < nvalid) ? *(const f32x4*)(src + (size_t)kk * ld + c4) : (f32x4){0.f, 0.f, 0.f, 0.f};
        scr[kk * 33 + c4] = v.x; scr[kk * 33 + c4 + 1] = v.y; scr[kk * 33 + c4 + 2] = v.z; scr[kk * 33 + c4 + 3] = v.w; }
    asm volatile("s_waitcnt lgkmcnt(0)" ::: "memory");
    const int c = lane & 7;
#pragma unroll
    for (int j = 0; j < 4; ++j) { const int n = (lane >> 3) + 8 * j; const LAS float* s = scr + (8 * c) * 33 + n;
        u32x4 o; o.x = cvt_pk_bf16(s[0 * 33], s[1 * 33]); o.y = cvt_pk_bf16(s[2 * 33], s[3 * 33]); o.z = cvt_pk_bf16(s[4 * 33], s[5 * 33]); o.w = cvt_pk_bf16(s[6 * 33], s[7 * 33]);
        *(u32x4*)(dst + (size_t)n * ldd + 8 * c) = o; }
    asm volatile("s_waitcnt lgkmcnt(0)" ::: "memory");
}
template <int MAP> __device__ __forceinline__ void transpose_w(const float* src, int K, int ldsrc, int nsrc, u16* dst, int ndst, LAS float* scr, int gw, int ngw, int lane) {
    const int nkb = K / 64, nitems = (ndst / 32) * nkb;
    for (int it = gw; it < nitems; it += ngw) {
        const int nb = it / nkb, kb = it % nkb, n0 = nb * 32, k0 = kb * 64;
        int c0 = n0;
        if (MAP == 1) { const int j = n0 >> 8, w = n0 & 255, q = w >> 6, r = w & 63; c0 = (r < 32) ? (j * 128 + 32 * q) : (FH + j * 128 + 32 * q); }
        int nvalid = nsrc - c0; nvalid = nvalid > 32 ? 32 : nvalid;
        tr_item(src + (size_t)k0 * ldsrc + c0, ldsrc, nvalid, dst + (size_t)n0 * K + k0, K, scr, lane);
    }
}

__device__ __forceinline__ void phase_prologue(LAS unsigned char* lds, const Params& P) {
    const int tid = opaque_tid(), lane = tid & 63, wid = tid >> 6, bid = obid(), nb = ogdim();
    unsigned char* ws = P.ws;
    {
        LAS float* sl = (LAS float*)lds;
        LAS float* red = sl + 17 * 1024;
        for (int i = tid; i < 17 * 1024; i += 512) { const int mb = i >> 10, k = i & 1023; const float v = mb < 16 ? P.c[mb * 1024 + k] : P.c_ctx[k]; sl[i] = siluf_(v); }
        BLOCK_SYNC();
        float* MOD = (float*)(ws + WS_MOD);
        for (int item = bid; item < 4 * 96; item += nb) {
            const int l = item / 96, n0 = (item % 96) * 64, col = tid & 63, kg = tid >> 6;
            float a[17];
#pragma unroll
            for (int i = 0; i < 17; ++i) a[i] = 0.f;
            const float* w = P.mod_w + ((size_t)l * 1024 + kg * 128) * 6144 + n0 + col;
            for (int kk = 0; kk < 128; ++kk) { const float wv = w[(size_t)kk * 6144];
#pragma unroll
                for (int i = 0; i < 17; ++i) a[i] += sl[i * 1024 + kg * 128 + kk] * wv; }
#pragma unroll
            for (int i = 0; i < 17; ++i) red[(kg * 17 + i) * 64 + col] = a[i];
            BLOCK_SYNC();
            for (int o = tid; o < 17 * 64; o += 512) { const int mb = o >> 6, cc = o & 63; float s = P.mod_b[l * 6144 + n0 + cc];
#pragma unroll
                for (int k8 = 0; k8 < 8; ++k8) s += red[(k8 * 17 + mb) * 64 + cc];
                MOD[((size_t)l * 17 + mb) * 6144 + n0 + cc] = s; }
            BLOCK_SYNC();
        }
    }
    BLOCK_SYNC();
    for (int i = bid * 512 + tid; i < 2048; i += nb * 512) ((float*)(ws + WS_SP8))[i] = 8.0f * log1pf(__expf(-P.lru_lambda[i]));
    LAS float* scr = (LAS float*)(lds + wid * 8448);
    const int gw = bid * 8 + wid, ngw = nb * 8;
    for (int l = 0; l < 4; ++l) {
        transpose_w<1>(P.ffn_w_up + (size_t)l * 1024 * F2, 1024, F2, F2, (u16*)(ws + WS_FFN_UP_T + l * SZ_FFN_UP_T), F2, scr, gw, ngw, lane);
        transpose_w<0>(P.ffn_w_down + (size_t)l * FH * 1024, FH, 1024, 1024, (u16*)(ws + WS_FFN_DN_T + l * SZ_FFN_DN_T), 1024, scr, gw, ngw, lane);
    }
    for (int j = 0; j < 2; ++j) {
        transpose_w<0>(P.cm_w_in + (size_t)j * 1024 * 4096, 1024, 4096, 4096, (u16*)(ws + WS_CM_IN_T) + (size_t)j * 4096 * 1024, 4096, scr, gw, ngw, lane);
        transpose_w<0>(P.cm_w_out + (size_t)j * 2048 * 1024, 2048, 1024, 1024, (u16*)(ws + WS_CM_OUT_T) + (size_t)j * 1024 * 2048, 1024, scr, gw, ngw, lane);
    }
    transpose_w<0>(P.lru_w_in, 1024, 2048, 2048, (u16*)(ws + WS_LRU_IN_T), 2048, scr, gw, ngw, lane);
    transpose_w<0>(P.lru_w_out, 1024, 1024, 1024, (u16*)(ws + WS_LRU_OUT_T), 1024, scr, gw, ngw, lane);
    transpose_w<0>(P.ml_w_in, 1024, 3088, 3088, (u16*)(ws + WS_ML_IN_T), 3328, scr, gw, ngw, lane);
    transpose_w<0>(P.ml_w_out, 1024, 1024, 1024, (u16*)(ws + WS_ML_OUT_T), 1024, scr, gw, ngw, lane);
    for (int q = 0; q < 32; ++q) {
        const int h = q >> 3, tn = (q >> 1) & 3, gate = q & 1, d = tn >> 1, jb = tn & 1;
        const float* src = (gate ? P.lru_w_ig : P.lru_w_rg) + (size_t)(d * 4 + h) * 256 * 256 + jb * 128;
        u16* dst = (u16*)(ws + WS_LRU_G_T) + ((size_t)h * 1024 + tn * 256 + gate * 128) * 256;
        transpose_w<0>(src, 256, 256, 128, dst, 128, scr, (gw + q * 16) % ngw, ngw, lane);
    }
}

__device__ __forceinline__ void phase_prenorm(const float* xl, const float* xc, const float* g, const float* modl, int shoff, int scoff, u16* H, int nrows) {
    const int tid_ = opaque_tid(); const int lane = tid_ & 63, gw = obid() * 8 + (tid_ >> 6), ngw = ogdim() * 8;
    for (int r = gw; r < nrows; r += ngw) {
        const bool lat = r < ML; const float* xr = lat ? xl + (size_t)r * 1024 : xc + (size_t)(r - ML) * 1024; const int mb = lat ? (r >> 12) : 16;
        f32x4 v[4]; float ss = 0.f;
#pragma unroll
        for (int j = 0; j < 4; ++j) { v[j] = ((const f32x4*)xr)[lane + 64 * j]; ss += (v[j].x * v[j].x + v[j].y * v[j].y) + (v[j].z * v[j].z + v[j].w * v[j].w); }
        const float rstd = rsqrtf(wave_sum(ss) * (1.0f / 1024.0f) + 1e-6f);
        const float* mp = modl + (size_t)mb * 6144;
#pragma unroll
        for (int j = 0; j < 4; ++j) { const int c = (lane + 64 * j) * 4;
            const f32x4 gg = *(const f32x4*)(g + c), sc = *(const f32x4*)(mp + scoff + c), sh = *(const f32x4*)(mp + shoff + c);
            const f32x4 y = v[j] * rstd * gg; const f32x4 hh = y * (sc + 1.0f) + sh;
            u32x2 o; o.x = cvt_pk_bf16(hh.x, hh.y); o.y = cvt_pk_bf16(hh.z, hh.w);
            *(u32x2*)(H + (size_t)r * 1024 + c) = o; }
    }
}
__device__ __forceinline__ void phase_pre0(const float* xl, const float* xc, const float* g, const float* modl, int scoff, u16* XB, float* RS, int nrows) {
    const int tid_ = opaque_tid(); const int lane = tid_ & 63, gw = obid() * 8 + (tid_ >> 6), ngw = ogdim() * 8;
    for (int r = gw; r < nrows; r += ngw) {
        const bool lat = r < ML; const float* xr = lat ? xl + (size_t)r * 1024 : xc + (size_t)(r - ML) * 1024; const int mb = lat ? (r >> 12) : 16;
        f32x4 v[4]; float ss = 0.f;
#pragma unroll
        for (int j = 0; j < 4; ++j) { v[j] = ((const f32x4*)xr)[lane + 64 * j]; ss += (v[j].x * v[j].x + v[j].y * v[j].y) + (v[j].z * v[j].z + v[j].w * v[j].w); }
        ss = wave_sum(ss);
        if (lane < 16) RS[(size_t)r * 16 + lane] = (lane == 0) ? ss : 0.f;
        const float* mp = modl + (size_t)mb * 6144;
#pragma unroll
        for (int j = 0; j < 4; ++j) { const int c = (lane + 64 * j) * 4;
            const f32x4 gg = *(const f32x4*)(g + c), sc = *(const f32x4*)(mp + scoff + c);
            const f32x4 hh = v[j] * gg * (sc + 1.0f);
            u32x2 o; o.x = cvt_pk_bf16(hh.x, hh.y); o.y = cvt_pk_bf16(hh.z, hh.w);
            *(u32x2*)(XB + ablk(r, c, 16)) = o; }
    }
}
__device__ __forceinline__ void shw_table(LAS unsigned char* lds, const float* modl, int shoff, const u16* Wt, int N, float* out) {
    LAS float* sh = (LAS float*)lds;
    const int tid = opaque_tid(), lane = tid & 63, wid = tid >> 6;
    BLOCK_SYNC();
    for (int i = tid; i < 17 * 1024; i += 512) sh[i] = modl[(size_t)(i >> 10) * 6144 + shoff + (i & 1023)];
    BLOCK_SYNC();
    for (int n = obid() * 8 + wid; n < N; n += ogdim() * 8) {
        float w[16]; { float t8[8]; unpack8(*(const u32x4*)(Wt + (size_t)n * 1024 + lane * 8), t8);
#pragma unroll
            for (int e = 0; e < 8; ++e) w[e] = t8[e];
            unpack8(*(const u32x4*)(Wt + (size_t)n * 1024 + 512 + lane * 8), t8);
#pragma unroll
            for (int e = 0; e < 8; ++e) w[8 + e] = t8[e]; }
        float res = 0.f;
#pragma unroll 1
        for (int mb = 0; mb < 17; ++mb) { const LAS float* s = sh + mb * 1024 + lane * 8; float a = 0.f;
#pragma unroll
            for (int e = 0; e < 8; ++e) a += w[e] * s[e] + w[8 + e] * s[512 + e];
            a = wave_sum(a); if (lane == mb) res = a; }
        if (lane < 17) out[(size_t)lane * N + n] = res;
    }
}
__device__ __forceinline__ void phase_final_norm(float* x, const float* g) {
    const int tid_ = opaque_tid(); const int lane = tid_ & 63, gw = obid() * 8 + (tid_ >> 6), ngw = ogdim() * 8;
    for (int r = gw; r < ML; r += ngw) {
        float* xr = x + (size_t)r * 1024; f32x4 v[4]; float ss = 0.f;
#pragma unroll
        for (int j = 0; j < 4; ++j) { v[j] = ((const f32x4*)xr)[lane + 64 * j]; ss += (v[j].x * v[j].x + v[j].y * v[j].y) + (v[j].z * v[j].z + v[j].w * v[j].w); }
        const float rstd = rsqrtf(wave_sum(ss) * (1.0f / 1024.0f) + 1e-6f);
#pragma unroll
        for (int j = 0; j < 4; ++j) { const int c = (lane + 64 * j) * 4; const f32x4 gg = *(const f32x4*)(g + c); ((f32x4*)xr)[lane + 64 * j] = v[j] * rstd * gg; }
    }
}

__device__ __forceinline__ void phase_cm_spatial(LAS unsigned char* lds, u16* U, const u16* V, const float* pstats, const float* w_s, const float* b_s, const float* v_g, const float* v_b, int nchunks) {
    constexpr int LW = 136;
    LAS u16* VT = (LAS u16*)lds;
    LAS u16* WP = (LAS u16*)(lds + 69632);
    LAS float* mu = (LAS float*)(lds + 104448); LAS float* rs = mu + 128; LAS float* t1 = rs + 128; LAS float* t2 = t1 + 128;
    const int tid = opaque_tid(), lane = tid & 63, w = tid >> 6, fr = lane & 15, fq = lane >> 4;
    for (int item = obid(); item < nchunks * 8; item += ogdim()) {
        const int ck = item >> 3, g = item & 7, r0 = ck * 128;
        if (tid < 128) { const float* ps = pstats + (size_t)(r0 + tid) * 64; float s = 0.f, ss = 0.f;
            for (int i = 0; i < 32; ++i) { s += ps[2 * i]; ss += ps[2 * i + 1]; }
            const float mean = s * (1.0f / 2048.0f); const float var = fmaxf(ss * (1.0f / 2048.0f) - mean * mean, 0.f);
            mu[tid] = mean; rs[tid] = rsqrtf(var + 1e-6f); }
        BLOCK_SYNC();
#pragma unroll
        for (int j = 0; j < 8; ++j) { const int pc = tid + 512 * j, q = pc & 127, c8 = pc >> 7;
            const u32x4 raw = *(const u32x4*)(V + (size_t)(r0 + q) * 2048 + g * 256 + c8 * 8);
            LAS u16* d = VT + (c8 * 8) * LW + q;
            d[0 * LW] = (u16)(raw.x & 0xffffu); d[1 * LW] = (u16)(raw.x >> 16); d[2 * LW] = (u16)(raw.y & 0xffffu); d[3 * LW] = (u16)(raw.y >> 16);
            d[4 * LW] = (u16)(raw.z & 0xffffu); d[5 * LW] = (u16)(raw.z >> 16); d[6 * LW] = (u16)(raw.w & 0xffffu); d[7 * LW] = (u16)(raw.w >> 16); }
        { const int pr = tid >> 2, part = tid & 3; const float* wrow = w_s + ((size_t)g * 128 + pr) * 128 + part * 32; float a1 = 0.f, a2 = 0.f;
            f32x4 wv4[8];
#pragma unroll
            for (int q4 = 0; q4 < 8; ++q4) wv4[q4] = ((const f32x4*)wrow)[q4];
#pragma unroll
            for (int q4 = 0; q4 < 8; ++q4) { const int q = part * 32 + q4 * 4; const f32x4 r4 = *(const LAS f32x4*)(rs + q), m4 = *(const LAS f32x4*)(mu + q);
                const unsigned p01 = cvt_pk_bf16(wv4[q4].x * r4.x, wv4[q4].y * r4.y), p23 = cvt_pk_bf16(wv4[q4].z * r4.z, wv4[q4].w * r4.w);
                *(LAS u32x2*)(WP + pr * LW + q) = (u32x2){p01, p23};
                a1 += (bf_lo(p01) * m4.x + bf_hi(p01) * m4.y) + (bf_lo(p23) * m4.z + bf_hi(p23) * m4.w); a2 += (wv4[q4].x + wv4[q4].y) + (wv4[q4].z + wv4[q4].w); }
            a1 += __shfl_xor(a1, 1); a1 += __shfl_xor(a1, 2); a2 += __shfl_xor(a2, 1); a2 += __shfl_xor(a2, 2);
            if (part == 0) { t1[pr] = a1; t2[pr] = a2; } }
        BLOCK_SYNC();
        f32x4 acc[8][2];
#pragma unroll
        for (int m = 0; m < 8; ++m) { acc[m][0] = (f32x4){0.f, 0.f, 0.f, 0.f}; acc[m][1] = (f32x4){0.f, 0.f, 0.f, 0.f}; }
#pragma unroll 1
        for (int k = 0; k < 4; ++k) {
            bf16x8 Vf[2];
#pragma unroll
            for (int n = 0; n < 2; ++n) Vf[n] = *(const LAS bf16x8*)(VT + (32 * w + 16 * n + fr) * LW + 32 * k + 8 * fq);
#pragma unroll
            for (int m = 0; m < 8; ++m) { const bf16x8 Wf = *(const LAS bf16x8*)(WP + (16 * m + fr) * LW + 32 * k + 8 * fq);
#pragma unroll
                for (int n = 0; n < 2; ++n) acc[m][n] = __builtin_amdgcn_mfma_f32_16x16x32_bf16(Vf[n], Wf, acc[m][n], 0, 0, 0); }
        }
        u32x2 ur8[8][2];
#pragma unroll
        for (int m = 0; m < 8; ++m)
#pragma unroll
            for (int n = 0; n < 2; ++n) ur8[m][n] = *(const u32x2*)(U + (size_t)(r0 + 16 * m + fr) * 2048 + g * 256 + 32 * w + 16 * n + 4 * fq);
        f32x4 vg4[2], vb4[2];
#pragma unroll
        for (int n = 0; n < 2; ++n) { const int cg_ = g * 256 + 32 * w + 16 * n + 4 * fq; vg4[n] = *(const f32x4*)(v_g + cg_); vb4[n] = *(const f32x4*)(v_b + cg_); }
#pragma unroll
        for (int m = 0; m < 8; ++m) { const int pp = 16 * m + fr; const float tt1 = t1[pp], tt2 = t2[pp], bsp = b_s[g * 128 + pp];
#pragma unroll
            for (int n = 0; n < 2; ++n) { const int cg_ = g * 256 + 32 * w + 16 * n + 4 * fq;
                u16* up = U + (size_t)(r0 + pp) * 2048 + cg_; const u32x2 ur = ur8[m][n];
                const float u0 = bf_lo(ur.x), u1 = bf_hi(ur.x), u2 = bf_lo(ur.y), u3 = bf_hi(ur.y);
                const float s0 = vg4[n].x * (acc[m][n][0] - tt1) + vb4[n].x * tt2 + bsp, s1 = vg4[n].y * (acc[m][n][1] - tt1) + vb4[n].y * tt2 + bsp;
                const float s2 = vg4[n].z * (acc[m][n][2] - tt1) + vb4[n].z * tt2 + bsp, s3 = vg4[n].w * (acc[m][n][3] - tt1) + vb4[n].w * tt2 + bsp;
                u32x2 o; o.x = cvt_pk_bf16(u0 * s0, u1 * s1); o.y = cvt_pk_bf16(u2 * s2, u3 * s3); *(u32x2*)up = o; } }
        BLOCK_SYNC();
    }
}

constexpr int CONV_NPRE = 11;
__device__ __forceinline__ void conv_lat_decode(int iu, int ntile, int j0, int& zbase_row, int& band, int& zg, int& c0) {
    const int cq = (iu >> 3) & 3, idx = (iu & 7) + 8 * (iu >> 5), tj = idx % ntile, rest = idx / ntile;
    band = rest & 7; const int b = rest >> 3; zbase_row = b * 4096 + band * 512;
    zg = tj * 4 + cq; c0 = (j0 + tj) * 128 + cq * 32;
}
__device__ __forceinline__ void conv_lat_prefetch(const u16* Z, int ld, int zbase_row, int band, int zg, const float* cw, const float* cb, int c0, int tid,
                                                  const int (&rel)[CONV_NPRE], const int (&flg)[CONV_NPRE], u32x4 (&pre)[CONV_NPRE], float (&wpre)[2]) {
    const u16* zb = Z + (((size_t)zg * MT + zbase_row) << 6);
#pragma unroll
    for (int s = 0; s < CONV_NPRE; ++s) { u32x4 v = (u32x4){0u, 0u, 0u, 0u};
        const bool ok = (flg[s] & 1) && !((flg[s] & 2) && band == 0) && !((flg[s] & 4) && band == 7);
        if (ok) v = *(const u32x4*)(zb + (ptrdiff_t)rel[s]);
        pre[s] = v; }
#pragma unroll
    for (int s = 0; s < 2; ++s) { const int i = tid + 512 * s; float v = 0.f;
        if (i < 9 * 64) { const int tap = i >> 6, ch = i & 63; v = cw[(size_t)tap * F2 + (ch < 32 ? c0 + ch : FH + c0 + ch - 32)]; }
        else if (i < 10 * 64) { const int ch = i & 63; v = cb[ch < 32 ? c0 + ch : FH + c0 + ch - 32]; }
        wpre[s] = v; }
}
__device__ __forceinline__ void phase_ffn_conv(LAS unsigned char* lds, const u16* Z, int ntile, int j0, const float* cw, const float* cb, u16* A2, bool with_ctx, unsigned long long& tpr) {
    LAS u16* T = (LAS u16*)lds;
    LAS float* Wc = (LAS float*)(lds + 100352);
    LAS _Float16* WcH = (LAS _Float16*)(lds + 100352 + 2560);
    const int tid = opaque_tid();
    const int n_lat = 16 * 8 * ntile * 4, n_all = n_lat + (with_ctx ? 16 * ntile * 4 : 0);
    const int ld = ntile * 256;
    u32x4 pre[CONV_NPRE]; float wpre[2];
    {
        int rel[CONV_NPRE], loff[CONV_NPRE], flg[CONV_NPRE];
#pragma unroll
        for (int s = 0; s < CONV_NPRE; ++s) { const int pc = tid + 512 * s; const int o = pc & 7, pos = pc >> 3, lr = pos / 66, lc = pos - lr * 66;
            const bool ex = pc < 10 * 66 * 8;
            rel[s] = ((lr - 1) * 64 + (lc - 1)) * 64 + o * 8; loff[s] = (pos * 64 + (o & 3) * 16 + (o >> 2) * 8);
            flg[s] = ((ex && lc >= 1 && lc <= 64) ? 1 : 0) | (lr == 0 ? 2 : 0) | (lr == 9 ? 4 : 0) | (ex ? 8 : 0); }
        const int oct = tid & 3, col = (tid >> 2) & 63, rh = tid >> 8;
        const int tb = ((4 * rh) * 66 + col) * 64 + oct * 16;
        int it = obid(); const int G = ogdim();
        int zrow = 0, band = 0, zg = 0, c0 = 0;
        if (it < n_lat) { conv_lat_decode(it, ntile, j0, zrow, band, zg, c0); conv_lat_prefetch(Z, ld, zrow, band, zg, cw, cb, c0, tid, rel, flg, pre, wpre); }
        while (it < n_lat) {
            unsigned long long q0 = 0; if (PROBE_CLASS >= 14 && PROBE_CLASS <= 16) q0 = wall_clock64();
#pragma unroll
            for (int s = 0; s < CONV_NPRE; ++s) if (flg[s] & 8) *(LAS u32x4*)(T + loff[s]) = pre[s];
#pragma unroll
            for (int s = 0; s < 2; ++s) { const int i = tid + 512 * s; if (i < 10 * 64) Wc[i] = wpre[s]; if (i < 9 * 64) WcH[i] = (_Float16)wpre[s]; }
            BLOCK_SYNC();
            unsigned long long q1 = 0; if (PROBE_CLASS >= 14 && PROBE_CLASS <= 16) { q1 = wall_clock64(); if (PROBE_CLASS == 14) tpr += q1 - q0; }
            const int crow = zrow, cc0 = c0;
            const int nxt = it + G;
            if (nxt < n_lat) { conv_lat_decode(nxt, ntile, j0, zrow, band, zg, c0); conv_lat_prefetch(Z, ld, zrow, band, zg, cw, cb, c0, tid, rel, flg, pre, wpre); }
            float gres[4][8];
#pragma unroll
            for (int half = 0; half < 2; ++half) {
                h2_t acch[4][4];
#pragma unroll
                for (int t = 0; t < 4; ++t)
#pragma unroll
                    for (int q = 0; q < 4; ++q) acch[t][q] = (h2_t){(_Float16)0.f, (_Float16)0.f};
#pragma unroll 1
                for (int dj = 0; dj < 3; ++dj) {
                    h2x4 wh[3];
#pragma unroll
                    for (int di = 0; di < 3; ++di) wh[di] = __builtin_bit_cast(h2x4, *(const LAS u32x4*)(WcH + (di * 3 + dj) * 64 + half * 32 + oct * 8));
                    u32x4 raw[6];
#pragma unroll
                    for (int rr = 0; rr < 6; ++rr) raw[rr] = *(const LAS u32x4*)(T + tb + (rr * 66 + dj) * 64 + half * 8);
#pragma unroll
                    for (int rr = 0; rr < 6; ++rr) { const h2x4 zh = __builtin_bit_cast(h2x4, raw[rr]);
#pragma unroll
                        for (int di = 0; di < 3; ++di) { const int t = rr - di; if (t >= 0 && t < 4) {
#pragma unroll
                            for (int q = 0; q < 4; ++q) acch[t][q] = wh[di].v[q] * zh.v[q] + acch[t][q]; } } }
                }
                float acc[4][8];
#pragma unroll
                for (int t = 0; t < 4; ++t)
#pragma unroll
                    for (int q = 0; q < 4; ++q) { acc[t][2 * q] = (float)acch[t][q].x + Wc[576 + half * 32 + oct * 8 + 2 * q]; acc[t][2 * q + 1] = (float)acch[t][q].y + Wc[576 + half * 32 + oct * 8 + 2 * q + 1]; }
                if (half == 0) {
#pragma unroll
                    for (int t = 0; t < 4; ++t)
#pragma unroll
                        for (int e = 0; e < 8; ++e) gres[t][e] = acc[t][e];
                } else {
#pragma unroll
                    for (int t = 0; t < 4; ++t) { float o8[8];
#pragma unroll
                        for (int e = 0; e < 8; ++e) o8[e] = siluf_(gres[t][e]) * acc[t][e];
                        *(u32x4*)(A2 + (size_t)(crow + (4 * rh + t) * 64 + col) * FH + cc0 + oct * 8) = pack8(o8); }
                }
            }
            unsigned long long q2 = 0; if (PROBE_CLASS >= 15 && PROBE_CLASS <= 16) { q2 = wall_clock64(); if (PROBE_CLASS == 15) tpr += q2 - q1; }
            BLOCK_SYNC();
            if (PROBE_CLASS == 16) tpr += wall_clock64() - q2;
            it = nxt;
        }
    }
    {
        const int oct = tid & 3, tk = tid >> 2, G = ogdim();
        const int n_ctx = n_all - n_lat;
        int it = obid();
        while (it < n_ctx) {
            const int cq = (it >> 3) & 3, idx = (it & 7) + 8 * (it >> 5), tj = idx % ntile, b = idx / ntile;
            const int base_row = ML + b * 256, c0 = (j0 + tj) * 128 + cq * 32;
            const u16* zb = Z + (((size_t)(tj * 4 + cq) * MT + base_row) << 6);
#pragma unroll
            for (int s = 0; s < 5; ++s) { const int pc = tid + 512 * s, o = pc & 7, lc = pc >> 3; u32x4 v = (u32x4){0u, 0u, 0u, 0u};
                if (pc < 258 * 8) { if (lc >= 1 && lc <= 256) v = *(const u32x4*)(zb + (lc - 1) * 64 + o * 8);
                    *(LAS u32x4*)(T + (lc * 64 + (o & 3) * 16 + (o >> 2) * 8)) = v; } }
#pragma unroll
            for (int s = 0; s < 2; ++s) { const int i = tid + 512 * s;
                if (i < 9 * 64) { const int tap = i >> 6, ch = i & 63; Wc[i] = cw[(size_t)tap * F2 + (ch < 32 ? c0 + ch : FH + c0 + ch - 32)]; }
                else if (i < 10 * 64) { const int ch = i & 63; Wc[i] = cb[ch < 32 ? c0 + ch : FH + c0 + ch - 32]; } }
            BLOCK_SYNC();
            float ag[2][8], au[2][8];
#pragma unroll
            for (int itr = 0; itr < 2; ++itr)
#pragma unroll
                for (int e = 0; e < 8; ++e) { ag[itr][e] = Wc[576 + oct * 8 + e]; au[itr][e] = Wc[576 + 32 + oct * 8 + e]; }
#pragma unroll
            for (int dj = 0; dj < 3; ++dj) { const int tap = 3 + dj;
                float wg[8], wu[8];
#pragma unroll
                for (int e = 0; e < 8; ++e) { wg[e] = Wc[tap * 64 + oct * 8 + e]; wu[e] = Wc[tap * 64 + 32 + oct * 8 + e]; }
#pragma unroll
                for (int itr = 0; itr < 2; ++itr) { const int col = itr * 128 + tk;
                    const LAS u16* tp = T + ((col + dj) * 64 + oct * 16);
                    float zgv[8], zuv[8]; unpack8h(*(const LAS u32x4*)tp, zgv); unpack8h(*(const LAS u32x4*)(tp + 8), zuv);
#pragma unroll
                    for (int e = 0; e < 8; ++e) { ag[itr][e] += wg[e] * zgv[e]; au[itr][e] += wu[e] * zuv[e]; } }
            }
#pragma unroll
            for (int itr = 0; itr < 2; ++itr) { const int col = itr * 128 + tk; float o8[8];
#pragma unroll
                for (int e = 0; e < 8; ++e) o8[e] = siluf_(ag[itr][e]) * au[itr][e];
                *(u32x4*)(A2 + (size_t)(base_row + col) * FH + c0 + oct * 8) = pack8(o8); }
            BLOCK_SYNC();
            it += G;
        }
    }
}

__device__ __forceinline__ void phase_lru_conv(const u16* XR, const float* cw  , const float* cb, u16* XCV) {
    const size_t total = (size_t)MT * 128, stride = (size_t)ogdim() * 512;
    const int tid_ = opaque_tid();
    for (size_t idx = (size_t)obid() * 512 + tid_; idx < total; idx += stride) {
        const int r = (int)(idx >> 7), oct = (int)(idx & 127), c = oct * 8;
        int t, len; if (r < ML) { t = r & 4095; len = 4096; } else { t = (r - ML) & 255; len = 256; }
        float a[8];
#pragma unroll
        for (int e = 0; e < 8; ++e) a[e] = cb[c + e];
#pragma unroll
        for (int k = 0; k < 4; ++k) { const int tt = t + k - 2; if (tt >= 0 && tt < len) { float xv[8]; unpack8(*(const u32x4*)(XR + (size_t)(r + k - 2) * 1024 + c), xv);
#pragma unroll
            for (int e = 0; e < 8; ++e) a[e] += cw[k * 1024 + c + e] * xv[e]; } }
        *(u32x4*)(XCV + (size_t)r * 1024 + c) = pack8(a);
    }
}

__device__ __forceinline__ void phase_lru_scanA(const u16* LA0, const u16* B0, const u16* LA1, const u16* B1, float* SEG) {
    const int tid = opaque_tid();
    for (int it = obid(); it < 272; it += ogdim()) {
        const int gt = it * 512 + tid, oct = gt & 127, dir = (gt >> 7) & 1, sid = gt >> 8;
        const u16* la = (dir ? LA1 : LA0) + (size_t)sid * 128 * 1024 + oct * 8; const u16* bb = (dir ? B1 : B0) + (size_t)sid * 128 * 1024 + oct * 8;
        float ps[8], e[8];
#pragma unroll
        for (int c = 0; c < 8; ++c) { ps[c] = 0.f; e[c] = 0.f; }
#pragma unroll 8
        for (int i = 0; i < 128; ++i) { const int t = dir ? 127 - i : i; float lg[8], bv[8]; unpack8(*(const u32x4*)(la + (size_t)t * 1024), lg); unpack8(*(const u32x4*)(bb + (size_t)t * 1024), bv);
#pragma unroll
            for (int c = 0; c < 8; ++c) { ps[c] += lg[c]; e[c] = __expf(lg[c]) * e[c] + bv[c]; } }
        float* so = SEG + (((size_t)dir * 544 + sid) * 1024 + oct * 8) * 2;
#pragma unroll
        for (int c = 0; c < 8; c += 2) *(f32x4*)(so + c * 2) = (f32x4){ps[c], e[c], ps[c + 1], e[c + 1]};
    }
}
__device__ __forceinline__ void lru_carry(const float* SEG, int sid, int dir, int oct, float (&st)[8]) {
    int b, pos;
    if (sid >= 512) { b = (sid - 512) >> 1; const int s = (sid - 512) & 1; pos = dir ? 1 - s : s; }
    else { b = sid >> 5; const int s = sid & 31; pos = 2 + (dir ? 31 - s : s); }
#pragma unroll
    for (int c = 0; c < 8; ++c) st[c] = 0.f;
    for (int p = 0; p < pos; ++p) {
        int ps_;
        if (p < 2) ps_ = 512 + 2 * b + (dir ? 1 - p : p); else ps_ = b * 32 + (dir ? 31 - (p - 2) : (p - 2));
        const float* so = SEG + (((size_t)dir * 544 + ps_) * 1024 + oct * 8) * 2;
#pragma unroll
        for (int c = 0; c < 8; c += 2) { const f32x4 v = *(const f32x4*)(so + c * 2); st[c] = __expf(v.x) * st[c] + v.y; st[c + 1] = __expf(v.z) * st[c + 1] + v.w; }
    }
}
__device__ __forceinline__ void phase_lru_scanC(const u16* LA0, u16* B0, const u16* LA1, const u16* B1, const float* SEG, const u16* Y, u16* G) {
    const int tid = opaque_tid();
    for (int it = obid(); it < 136; it += ogdim()) {
        const int gt = it * 512 + tid, oct = gt & 127, sid = gt >> 7; const size_t base = (size_t)sid * 128 * 1024 + oct * 8;
        float h[8];
        lru_carry(SEG, sid, 0, oct, h);
#pragma unroll 1
        for (int t0 = 0; t0 < 128; t0 += 8) { u32x4 la8[8], b8[8];
#pragma unroll
            for (int k = 0; k < 8; ++k) { const size_t o = base + (size_t)(t0 + k) * 1024; la8[k] = *(const u32x4*)(LA0 + o); b8[k] = *(const u32x4*)(B0 + o); }
#pragma unroll
            for (int k = 0; k < 8; ++k) { const size_t o = base + (size_t)(t0 + k) * 1024; float lg[8], bv[8]; unpack8(la8[k], lg); unpack8(b8[k], bv);
#pragma unroll
                for (int c = 0; c < 8; ++c) h[c] = __expf(lg[c]) * h[c] + bv[c];
                *(u32x4*)(B0 + o) = pack8(h); } }
        lru_carry(SEG, sid, 1, oct, h);
#pragma unroll 1
        for (int i0 = 0; i0 < 128; i0 += 4) { u32x4 la4[4], b4[4], hf4[4], y4[4];
#pragma unroll
            for (int k = 0; k < 4; ++k) { const size_t o = base + (size_t)(127 - i0 - k) * 1024; la4[k] = *(const u32x4*)(LA1 + o); b4[k] = *(const u32x4*)(B1 + o); hf4[k] = *(const u32x4*)(B0 + o); y4[k] = *(const u32x4*)(Y + o); }
#pragma unroll
            for (int k = 0; k < 4; ++k) { const size_t o = base + (size_t)(127 - i0 - k) * 1024; float lg[8], bv[8], hf[8], yv[8], g8[8];
                unpack8(la4[k], lg); unpack8(b4[k], bv); unpack8(hf4[k], hf); unpack8(y4[k], yv);
#pragma unroll
                for (int c = 0; c < 8; ++c) { h[c] = __expf(lg[c]) * h[c] + bv[c]; g8[c] = (hf[c] + h[c]) * yv[c]; }
                *(u32x4*)(G + o) = pack8(g8); } }
    }
}

__device__ __forceinline__ void phase_mlstm(LAS unsigned char* lds, const u16* Q, const u16* Kx, const u16* V, const float* gates, u16* HF, u16* HB) {
    constexpr int LW = 136;
    LAS u16* R1 = (LAS u16*)lds;
    LAS u16* R2 = R1 + 128 * LW;
    LAS u16* VTs = R2 + 128 * LW;
    LAS u16* CTs = VTs + 128 * LW;
    LAS float* fb = (LAS float*)(CTs + 128 * LW);
    LAS float *lfv = fb, *igv = fb + 128, *bcum = fb + 256, *mtv = fb + 384, *iwv = fb + 512, *wv = fb + 640, *nvec = fb + 768, *qn = fb + 896, *den = fb + 1024, *rs2 = fb + 1152;
    const int tid = opaque_tid(), lane = tid & 63, wid = tid >> 6, wr = wid >> 1, wc = wid & 1, fr = lane & 15, fq = lane >> 4;
    for (int item = obid(); item < 256; item += ogdim()) {
        const int half = item & 1, dir = (item >> 1) & 1, h = (item >> 2) & 3, b = item >> 4;
        u16* HO = dir ? HB : HF;
        f32x4 accC[2][4];
#pragma unroll
        for (int a = 0; a < 2; ++a)
#pragma unroll
            for (int n = 0; n < 4; ++n) accC[a][n] = (f32x4){0.f, 0.f, 0.f, 0.f};
        for (int i = tid; i < 128 * LW / 2; i += 512) ((LAS unsigned*)CTs)[i] = 0u;
        if (tid < 128) nvec[tid] = 0.f;
        float mstate = 0.f;
        BLOCK_SYNC();
        for (int step = 0; step < 34; ++step) {
            int base;
            if (step < 2) { const int cc = dir ? 1 - step : step; base = ML + b * 256 + cc * 128; }
            else { const int lc = step - 2, cc = dir ? 31 - lc : lc; base = b * 4096 + cc * 128; }
            u32x4 kreg[4];
#pragma unroll
            for (int j = 0; j < 4; ++j) { const int pc = tid + 512 * j, i = pc & 127, c8 = pc >> 7; const size_t row = (size_t)base + (dir ? 127 - i : i);
                const u32x4 q16 = *(const u32x4*)(Q + row * 512 + h * 128 + c8 * 8); *(LAS u32x4*)(R1 + i * LW + c8 * 8) = q16;
                kreg[j] = *(const u32x4*)(Kx + row * 512 + h * 128 + c8 * 8); *(LAS u32x4*)(R2 + i * LW + c8 * 8) = kreg[j];
                const u32x4 raw = *(const u32x4*)(V + row * 1024 + h * 256 + half * 128 + c8 * 8);
                LAS u16* d = VTs + (c8 * 8) * LW + i;
                d[0 * LW] = (u16)(raw.x & 0xffffu); d[1 * LW] = (u16)(raw.x >> 16); d[2 * LW] = (u16)(raw.y & 0xffffu); d[3 * LW] = (u16)(raw.y >> 16);
                d[4 * LW] = (u16)(raw.z & 0xffffu); d[5 * LW] = (u16)(raw.z >> 16); d[6 * LW] = (u16)(raw.w & 0xffffu); d[7 * LW] = (u16)(raw.w >> 16); }
            if (tid < 128) { const size_t row = (size_t)base + (dir ? 127 - tid : tid); igv[tid] = gates[row * 16 + dir * 8 + h];
                const float f = gates[row * 16 + dir * 8 + 4 + h]; lfv[tid] = fminf(f, 0.f) - log1pf(__expf(-fabsf(f))); }
            BLOCK_SYNC();
            if (tid < 64) {
                const float l0 = lfv[2 * tid], l1 = lfv[2 * tid + 1], i0 = igv[2 * tid], i1 = igv[2 * tid + 1];
                float ps = l0 + l1;
#pragma unroll
                for (int o = 1; o < 64; o <<= 1) { const float v = __shfl_up(ps, o); if (tid >= o) ps += v; }
                const float b1 = ps, b0 = ps - l1;
                const float g0 = i0 - b0, g1 = i1 - b1;
                float pmx = fmaxf(g0, g1);
#pragma unroll
                for (int o = 1; o < 64; o <<= 1) { const float v = __shfl_up(pmx, o); if (tid >= o) pmx = fmaxf(pmx, v); }
                float pprev = __shfl_up(pmx, 1); if (tid == 0) pprev = -INFINITY;
                const float pm0 = fmaxf(pprev, g0), pm1 = pmx;
                const float mt0 = b0 + fmaxf(mstate, pm0), mt1 = b1 + fmaxf(mstate, pm1);
                bcum[2 * tid] = b0; bcum[2 * tid + 1] = b1; mtv[2 * tid] = mt0; mtv[2 * tid + 1] = mt1;
                iwv[2 * tid] = __expf(b0 + mstate - mt0); iwv[2 * tid + 1] = __expf(b1 + mstate - mt1);
            } else if (tid >= 128 && tid < 256) { const int t = tid - 128; float dq = 0.f;
#pragma unroll 2
                for (int c8 = 0; c8 < 16; ++c8) { float qv[8]; unpack8(*(const LAS u32x4*)(R1 + t * LW + c8 * 8), qv);
#pragma unroll
                    for (int e = 0; e < 8; ++e) dq += qv[e] * nvec[c8 * 8 + e]; }
                qn[t] = dq; }
            BLOCK_SYNC();
            const float m_new = mtv[127], b_end = bcum[127], decay = __expf(b_end + mstate - m_new);
            if (tid < 128) wv[tid] = __expf(b_end - bcum[tid] + igv[tid] - m_new);
            f32x4 accS[2][4], accH[2][4];
#pragma unroll
            for (int a = 0; a < 2; ++a)
#pragma unroll
                for (int n = 0; n < 4; ++n) { accS[a][n] = (f32x4){0.f, 0.f, 0.f, 0.f}; accH[a][n] = (f32x4){0.f, 0.f, 0.f, 0.f}; }
#pragma unroll 1
            for (int k = 0; k < 4; ++k) {
                bf16x8 Qf[2];
#pragma unroll
                for (int a = 0; a < 2; ++a) Qf[a] = *(const LAS bf16x8*)(R1 + (32 * wr + 16 * a + fr) * LW + 32 * k + 8 * fq);
#pragma unroll
                for (int n = 0; n < 4; ++n) { const bf16x8 Kf = *(const LAS bf16x8*)(R2 + (64 * wc + 16 * n + fr) * LW + 32 * k + 8 * fq);
#pragma unroll
                    for (int a = 0; a < 2; ++a) accS[a][n] = __builtin_amdgcn_mfma_f32_16x16x32_bf16(Kf, Qf[a], accS[a][n], 0, 0, 0); }
#pragma unroll
                for (int n = 0; n < 4; ++n) { const bf16x8 Cf = *(const LAS bf16x8*)(CTs + (64 * wc + 16 * n + fr) * LW + 32 * k + 8 * fq);
#pragma unroll
                    for (int a = 0; a < 2; ++a) accH[a][n] = __builtin_amdgcn_mfma_f32_16x16x32_bf16(Cf, Qf[a], accH[a][n], 0, 0, 0); }
            }
            BLOCK_SYNC();
#pragma unroll
            for (int a = 0; a < 2; ++a) { const int t = 32 * wr + 16 * a + fr; const float bt = bcum[t], mtt = mtv[t]; float rsum = 0.f;
#pragma unroll
                for (int n = 0; n < 4; ++n) { const int s0 = 64 * wc + 16 * n + 4 * fq; float sv[4];
#pragma unroll
                    for (int j = 0; j < 4; ++j) { const int s = s0 + j; const float dwv = (s <= t) ? __expf(bt - bcum[s] + igv[s] - mtt) : 0.f; sv[j] = accS[a][n][j] * dwv; rsum += sv[j]; }
                    u32x2 o; o.x = cvt_pk_bf16(sv[0], sv[1]); o.y = cvt_pk_bf16(sv[2], sv[3]); *(LAS u32x2*)(R2 + t * LW + s0) = o; }
                rsum += __shfl_xor(rsum, 16); rsum += __shfl_xor(rsum, 32); if (fq == 0) rs2[t * 2 + wc] = rsum; }
#pragma unroll
            for (int j = 0; j < 4; ++j) { const int pc = tid + 512 * j, i = pc & 127, c8 = pc >> 7; const float wgt = wv[i]; float kv[8]; unpack8(kreg[j], kv);
                LAS u16* d = R1 + (c8 * 8) * LW + i;
#pragma unroll
                for (int e = 0; e < 8; ++e) d[e * LW] = f2bf(kv[e] * wgt); }
            BLOCK_SYNC();
            if (tid < 128) { float sn = 0.f;
#pragma unroll 2
                for (int c8 = 0; c8 < 16; ++c8) { float kv[8]; unpack8(*(const LAS u32x4*)(R1 + tid * LW + c8 * 8), kv);
#pragma unroll
                    for (int e = 0; e < 8; ++e) sn += kv[e]; }
                nvec[tid] = decay * nvec[tid] + sn;
            } else if (tid < 256) { const int t = tid - 128; den[t] = iwv[t] * qn[t] + rs2[2 * t] + rs2[2 * t + 1]; }
#pragma unroll
            for (int a = 0; a < 2; ++a) { const float iw = iwv[32 * wr + 16 * a + fr];
#pragma unroll
                for (int n = 0; n < 4; ++n) { accH[a][n] = accH[a][n] * iw; accC[a][n] = accC[a][n] * decay; } }
#pragma unroll 1
            for (int k = 0; k < 4; ++k) {
                bf16x8 Sf[2], VTf[2];
#pragma unroll
                for (int a = 0; a < 2; ++a) { Sf[a] = *(const LAS bf16x8*)(R2 + (32 * wr + 16 * a + fr) * LW + 32 * k + 8 * fq); VTf[a] = *(const LAS bf16x8*)(VTs + (32 * wr + 16 * a + fr) * LW + 32 * k + 8 * fq); }
#pragma unroll
                for (int n = 0; n < 4; ++n) { const bf16x8 Vf = *(const LAS bf16x8*)(VTs + (64 * wc + 16 * n + fr) * LW + 32 * k + 8 * fq);
                    const bf16x8 KTf = *(const LAS bf16x8*)(R1 + (64 * wc + 16 * n + fr) * LW + 32 * k + 8 * fq);
#pragma unroll
                    for (int a = 0; a < 2; ++a) { accH[a][n] = __builtin_amdgcn_mfma_f32_16x16x32_bf16(Vf, Sf[a], accH[a][n], 0, 0, 0);
                        accC[a][n] = __builtin_amdgcn_mfma_f32_16x16x32_bf16(KTf, VTf[a], accC[a][n], 0, 0, 0); } }
            }
            BLOCK_SYNC();
#pragma unroll
            for (int a = 0; a < 2; ++a) { const int t = 32 * wr + 16 * a + fr; const float dn = fmaxf(fabsf(den[t]), __expf(-mtv[t])); const float inv = __builtin_amdgcn_rcpf(dn);
                const size_t row = (size_t)base + (dir ? 127 - t : t);
#pragma unroll
                for (int n = 0; n < 4; ++n) { const int e0 = 64 * wc + 16 * n + 4 * fq;
                    u32x2 o; o.x = cvt_pk_bf16(accH[a][n][0] * inv, accH[a][n][1] * inv); o.y = cvt_pk_bf16(accH[a][n][2] * inv, accH[a][n][3] * inv);
                    *(u32x2*)(HO + row * 1024 + h * 256 + half * 128 + e0) = o;
                    u32x2 cpk; cpk.x = cvt_pk_bf16(accC[a][n][0], accC[a][n][1]); cpk.y = cvt_pk_bf16(accC[a][n][2], accC[a][n][3]);
                    *(LAS u32x2*)(CTs + (32 * wr + 16 * a + fr) * LW + e0) = cpk; } }
            mstate = m_new;
            BLOCK_SYNC();
        }
    }
}
__device__ __forceinline__ void phase_ml_readout(const u16* HF, const u16* HB, const u16* O, const float* ng, u16* G) {
    const int tid_ = opaque_tid(); const int lane = tid_ & 63, gw = obid() * 8 + (tid_ >> 6), ngw = ogdim() * 8;
    for (int r = gw; r < MT; r += ngw) { const size_t off = (size_t)r * 1024 + lane * 16;
        float hs[16], a[8], bq[8];
        unpack8(*(const u32x4*)(HF + off), a); unpack8(*(const u32x4*)(HB + off), bq);
#pragma unroll
        for (int e = 0; e < 8; ++e) hs[e] = a[e] + bq[e];
        unpack8(*(const u32x4*)(HF + off + 8), a); unpack8(*(const u32x4*)(HB + off + 8), bq);
#pragma unroll
        for (int e = 0; e < 8; ++e) hs[8 + e] = a[e] + bq[e];
        float ss = 0.f;
#pragma unroll
        for (int e = 0; e < 16; ++e) ss += hs[e] * hs[e];
        ss += __shfl_xor(ss, 1); ss += __shfl_xor(ss, 2); ss += __shfl_xor(ss, 4); ss += __shfl_xor(ss, 8);
        const float rstd = __builtin_amdgcn_rsqf(ss * (1.0f / 256.0f) + 1e-6f);
        float o0[8], o1[8], g0[8], g1[8];
        unpack8(*(const u32x4*)(O + off), o0); unpack8(*(const u32x4*)(O + off + 8), o1);
#pragma unroll
        for (int e = 0; e < 8; ++e) { g0[e] = o0[e] * hs[e] * rstd * ng[lane * 16 + e]; g1[e] = o1[e] * hs[8 + e] * rstd * ng[lane * 16 + 8 + e]; }
        *(u32x4*)(G + off) = pack8(g0); *(u32x4*)(G + off + 8) = pack8(g1);
    }
}


#define XB_TMO      128
#define XB_XCNT(j)  (256  + 64 * (j))
#define XB_XSUB(j)  (1280 + 64 * (j))
#define XB_XGEN(j)  (2304 + 64 * (j))
#define XB_TOP      3328
#define XB_TOPGEN   3392
#define XCD_BAR_WORDS 3456
#define XB_SPIN_CAP (1u << 22)
__device__ __forceinline__ unsigned xb_ld(unsigned* p)              { return __hip_atomic_load(p, __ATOMIC_RELAXED, __HIP_MEMORY_SCOPE_AGENT); }
__device__ __forceinline__ unsigned xb_add(unsigned* p, unsigned v) { return __hip_atomic_fetch_add(p, v, __ATOMIC_RELAXED, __HIP_MEMORY_SCOPE_AGENT); }
__device__ __forceinline__ unsigned xb_xcc_id() { return (unsigned)__builtin_amdgcn_s_getreg((3 << 11) | 20) & 0xFu; }
#define XB_SPIN(cond, bar) do { unsigned _sp = 0; while (cond) { __builtin_amdgcn_s_sleep(1); \
    if ((++_sp & 255u) == 0u) { if (xb_ld(&(bar)[XB_TMO])) break; if (_sp > XB_SPIN_CAP) { atomicAdd(&(bar)[XB_TMO], 1u); break; } } } } while (0)
__device__ __forceinline__ void xcd_barrier_complete(unsigned* bar, unsigned x, unsigned& nloc, unsigned& nx) {
    const unsigned G = gridDim.x * gridDim.y * gridDim.z;
    unsigned sum, cnt, mine, sp = 0u;
    for (;;) {
        sum = 0u; cnt = 0u; mine = 0u;
#pragma unroll
        for (unsigned j = 0; j < 16; ++j) { const unsigned c = xb_ld(&bar[XB_XCNT(j)]); sum += c; cnt += (c > 0u) ? 1u : 0u; mine = (j == x) ? c : mine; }
        if (sum == G) break;
        __builtin_amdgcn_s_sleep(1);
        if ((++sp & 255u) == 0u) { if (xb_ld(&bar[XB_TMO])) break; if (sp > XB_SPIN_CAP) { atomicAdd(&bar[XB_TMO], 1u); break; } }
    }
    nloc = mine > 0u ? mine : 1u; nx = cnt > 0u ? cnt : 1u;
}
__device__ __forceinline__ void xcd_barrier(unsigned* bar, volatile LAS unsigned* st) {
    asm volatile("s_waitcnt vmcnt(0)" ::: "memory");
    __syncthreads();
    if (threadIdx.x == 0) {
        const unsigned x = xb_xcc_id();
        __builtin_amdgcn_s_waitcnt(0);
        unsigned nloc = st[0], nx = st[1];
        if (nloc == 0u) { xcd_barrier_complete(bar, x, nloc, nx); st[0] = nloc; st[1] = nx; }
        const unsigned old = xb_add(&bar[XB_XSUB(x)], 1u);
        const unsigned gen = old / nloc;
        if (old + 1u == (gen + 1u) * nloc) {
            __builtin_amdgcn_fence(__ATOMIC_RELEASE, "agent");
            asm volatile("s_waitcnt vmcnt(0)" ::: "memory");
            const unsigned og = xb_add(&bar[XB_TOP], 1u);
            const unsigned tg = og / nx;
            if (og + 1u == (tg + 1u) * nx) xb_add(&bar[XB_TOPGEN], 1u);
            else XB_SPIN(xb_ld(&bar[XB_TOPGEN]) == tg, bar);
            __builtin_amdgcn_fence(__ATOMIC_ACQUIRE, "agent");
            xb_add(&bar[XB_XGEN(x)], 1u);
            asm volatile("s_waitcnt vmcnt(0)" ::: "memory");
        } else {
            XB_SPIN(xb_ld(&bar[XB_XGEN(x)]) == gen, bar);
            __builtin_amdgcn_fence(__ATOMIC_ACQUIRE, "agent");
            asm volatile("s_waitcnt vmcnt(0)" ::: "memory");
        }
    }
    __syncthreads();
}

constexpr int PTAB_OFF = LDS_BYTES - 512;
#define SYNC0(c) do { grid.sync(); if (PROBE_CLASS) { const unsigned long long _n = wall_clock64(); if (PROBE_CLASS == (c)) tacc += _n - pt0; pt0 = _n; if (PROBE_CLASS == 10) { cyc0 = clock64(); } } } while (0)
#define SYNC(c) do { xcd_barrier((unsigned*)WSP(WS_BAR), (volatile LAS unsigned*)(lds + PTAB_OFF + 384)); if (PROBE_CLASS) { const unsigned long long _n = wall_clock64(); if (PROBE_CLASS == (c)) tacc += _n - pt0; pt0 = _n; if (PROBE_CLASS == 10) { const unsigned long long _c = clock64(); if ((c) == 1) cycacc += _c - cyc0; cyc0 = _c; } } } while (0)
enum { I_X = 0, I_C, I_CTX, I_CCTX, I_N1G, I_N2G, I_MODW, I_MODB, I_FUP, I_FCW, I_FCB, I_FDN, I_CMIN, I_CMBIN, I_CMVG, I_CMVB, I_CMWS, I_CMBS, I_CMOUT,
       I_LIN, I_LCW, I_LCB, I_LWRG, I_LBRG, I_LWIG, I_LBIG, I_LLAM, I_LOUT, I_MIN, I_MBG, I_MNG, I_MOUT, I_FNG, I_OUT, I_WS };
__device__ __forceinline__ unsigned char* getp(LAS unsigned char* lds, int idx) {
    unsigned a = PTAB_OFF; asm volatile("" : "+v"(a));
    volatile LAS unsigned* t = (volatile LAS unsigned*)(lds + a);
    unsigned lo = t[2 * idx], hi = t[2 * idx + 1];
    lo = __builtin_amdgcn_readfirstlane(lo); hi = __builtin_amdgcn_readfirstlane(hi);
    return (unsigned char*)(((unsigned long long)hi << 32) | (unsigned long long)lo);
}
#define GF(i) ((const float*)getp(lds, (i)))
#define WSP(off) (getp(lds, I_WS) + (off))

__global__ void __launch_bounds__(512, 2) mega_fwd(Params P) {
    extern __shared__ __attribute__((aligned(16))) unsigned char shm[];
    LAS unsigned char* lds = (LAS unsigned char*)shm;
    cg::grid_group grid = cg::this_grid();
    if (threadIdx.x < 35) { const unsigned long long v = ((const unsigned long long*)&P)[threadIdx.x]; LAS unsigned* t = (LAS unsigned*)(lds + PTAB_OFF); t[2 * threadIdx.x] = (unsigned)v; t[2 * threadIdx.x + 1] = (unsigned)(v >> 32); }
    if (threadIdx.x == 0) { LAS unsigned* stw = (LAS unsigned*)(lds + PTAB_OFF + 384); stw[0] = 0u; stw[1] = 0u; stw[2] = 0u; stw[3] = 0u; }
    BLOCK_SYNC();
    if (threadIdx.x == 0) (void)xb_add(&((unsigned*)P.ws + WS_BAR / 4)[XB_XCNT(xb_xcc_id())], 1u);
    unsigned long long tacc = 0, pt0 = PROBE_CLASS ? wall_clock64() : 0ull, nkt = 0, cyc0 = 0, cycacc = 0;
    phase_prologue(lds, P);
    SYNC0(7);
    {
        float* SHW = (float*)WSP(WS_SHW); const float* MOD = (const float*)WSP(WS_MOD);
        shw_table(lds, MOD + (size_t)0 * 17 * 6144, 0, (const u16*)WSP(WS_CM_IN_T), 4096, SHW + SHW_IN_OFF0);
        shw_table(lds, MOD + (size_t)1 * 17 * 6144, 0, (const u16*)WSP(WS_LRU_IN_T), 2048, SHW + SHW_IN_OFF1);
        shw_table(lds, MOD + (size_t)2 * 17 * 6144, 0, (const u16*)WSP(WS_ML_IN_T), 3328, SHW + SHW_IN_OFF2);
        shw_table(lds, MOD + (size_t)3 * 17 * 6144, 0, (const u16*)WSP(WS_CM_IN_T) + (size_t)4096 * 1024, 4096, SHW + SHW_IN_OFF3);
#pragma unroll 1
        for (int l = 0; l < 4; ++l) shw_table(lds, MOD + (size_t)l * 17 * 6144, 3072, (const u16*)WSP(WS_FFN_UP_T + l * SZ_FFN_UP_T), F2, SHW + SHW_UP_OFF + (size_t)l * 17 * F2);
        phase_pre0(GF(I_X), GF(I_CTX), GF(I_N1G), MOD, 1024, (u16*)WSP(WS_ACT), (float*)WSP(WS_RS), MT);
    }
    SYNC(3);

#pragma unroll 1
    for (int l = 0; l < 4; ++l) {
        const int kind = l % 3, j = l / 3; const bool last = (l == 3);
        const int nM = last ? 256 : 272, nrows = last ? ML : MT;
        g8::Desc dout{};
        if (kind == 0) {
            { g8::Desc d{}; d.A = (const u16*)WSP(WS_ACT); d.Bt = (const u16*)WSP(WS_CM_IN_T) + (size_t)j * 4096 * 1024; d.lda = 1024; d.ldb = 1024; d.K = 1024; d.nM = nM; d.nN = 16; d.nZ = 1; d.ablk = 1;
              Epi<M_CMIN> E{}; E.p.o0 = (u16*)WSP(WS_ACT + SLOT); E.p.o1 = (u16*)WSP(WS_ACT + 3 * SLOT); E.p.f0 = (float*)WSP(WS_ACT + 6 * SLOT); E.p.bias = GF(I_CMBIN) + j * 4096; E.p.rsr = (const float*)WSP(WS_RS); E.p.shw = (const float*)WSP(WS_SHW) + (l == 0 ? SHW_IN_OFF0 : SHW_IN_OFF3); E.p.shwld = 4096;
              g8::gemm_phase(lds, d, E, tacc, nkt); }
            SYNC(1);
            phase_cm_spatial(lds, (u16*)WSP(WS_ACT + SLOT), (const u16*)WSP(WS_ACT + 3 * SLOT), (const float*)WSP(WS_ACT + 6 * SLOT), GF(I_CMWS) + (size_t)j * 8 * 128 * 128, GF(I_CMBS) + j * 8 * 128,
                             GF(I_CMVG) + j * 2048, GF(I_CMVB) + j * 2048, nrows / 128);
            SYNC(4);
            dout.A = (const u16*)WSP(WS_ACT + SLOT); dout.Bt = (const u16*)WSP(WS_CM_OUT_T) + (size_t)j * 1024 * 2048; dout.lda = 2048; dout.ldb = 2048; dout.K = 2048;
        } else if (kind == 1) {
            { g8::Desc d{}; d.A = (const u16*)WSP(WS_ACT); d.Bt = (const u16*)WSP(WS_LRU_IN_T); d.lda = 1024; d.ldb = 1024; d.K = 1024; d.nM = nM; d.nN = 8; d.nZ = 1; d.ablk = 1;
              Epi<M_LRUIN> E{}; E.p.o0 = (u16*)WSP(WS_ACT + SLOT); E.p.o1 = (u16*)WSP(WS_ACT + 2 * SLOT); E.p.rsr = (const float*)WSP(WS_RS); E.p.shw = (const float*)WSP(WS_SHW) + SHW_IN_OFF1; E.p.shwld = 2048;
              g8::gemm_phase(lds, d, E, tacc, nkt); }
            SYNC(1);
            phase_lru_conv((const u16*)WSP(WS_ACT + 2 * SLOT), GF(I_LCW), GF(I_LCB), (u16*)WSP(WS_ACT + 3 * SLOT));
            SYNC(3);
            { g8::Desc d{}; d.A = (const u16*)WSP(WS_ACT + 3 * SLOT); d.Bt = (const u16*)WSP(WS_LRU_G_T); d.lda = 1024; d.ldb = 256; d.K = 256; d.nM = nM; d.nN = 4; d.nZ = 4; d.zA = 256; d.zB = (size_t)1024 * 256;
              Epi<M_LRUG> E{}; E.p.o0 = (u16*)WSP(WS_ACT); E.p.o1 = (u16*)WSP(WS_ACT + 2 * SLOT);
              E.p.q0 = GF(I_LBRG); E.p.q1 = GF(I_LBIG); E.p.q2 = (const float*)WSP(WS_SP8); E.p.bsrc = (const u16*)WSP(WS_ACT + 3 * SLOT);
              g8::gemm_phase(lds, d, E, tacc, nkt); }
            SYNC(1);
            phase_lru_scanA((const u16*)WSP(WS_ACT), (const u16*)WSP(WS_ACT + 2 * SLOT), (const u16*)WSP(WS_ACT + 4 * SLOT), (const u16*)WSP(WS_ACT + 5 * SLOT), (float*)WSP(WS_SEG));
            SYNC(6);
            phase_lru_scanC((const u16*)WSP(WS_ACT), (u16*)WSP(WS_ACT + 2 * SLOT), (const u16*)WSP(WS_ACT + 4 * SLOT), (const u16*)WSP(WS_ACT + 5 * SLOT), (const float*)WSP(WS_SEG),
                            (const u16*)WSP(WS_ACT + SLOT), (u16*)WSP(WS_ACT + 3 * SLOT));
            SYNC(6);
            dout.A = (const u16*)WSP(WS_ACT + 3 * SLOT); dout.Bt = (const u16*)WSP(WS_LRU_OUT_T); dout.lda = 1024; dout.ldb = 1024; dout.K = 1024;
        } else {
            { g8::Desc d{}; d.A = (const u16*)WSP(WS_ACT); d.Bt = (const u16*)WSP(WS_ML_IN_T); d.lda = 1024; d.ldb = 1024; d.K = 1024; d.nM = nM; d.nN = 13; d.nZ = 1; d.ablk = 1;
              Epi<M_MLIN> E{}; E.p.o0 = (u16*)WSP(WS_ACT + SLOT); E.p.o1 = (u16*)WSP(WS_ACT + SLOT) + (size_t)MT * 512; E.p.o2 = (u16*)WSP(WS_ACT + 2 * SLOT); E.p.o3 = (u16*)WSP(WS_ACT + 3 * SLOT);
              E.p.f0 = (float*)WSP(WS_ACT + 6 * SLOT); E.p.bias = GF(I_MBG); E.p.rsr = (const float*)WSP(WS_RS); E.p.shw = (const float*)WSP(WS_SHW) + SHW_IN_OFF2; E.p.shwld = 3328;
              g8::gemm_phase(lds, d, E, tacc, nkt); }
            SYNC(1);
            phase_mlstm(lds, (const u16*)WSP(WS_ACT + SLOT), (const u16*)WSP(WS_ACT + SLOT) + (size_t)MT * 512, (const u16*)WSP(WS_ACT + 2 * SLOT), (const float*)WSP(WS_ACT + 6 * SLOT),
                        (u16*)WSP(WS_ACT + 4 * SLOT), (u16*)WSP(WS_ACT + 5 * SLOT));
            SYNC(5);
            phase_ml_readout((const u16*)WSP(WS_ACT + 4 * SLOT), (const u16*)WSP(WS_ACT + 5 * SLOT), (const u16*)WSP(WS_ACT + 3 * SLOT), GF(I_MNG), (u16*)WSP(WS_ACT + 3 * SLOT));
            SYNC(3);
            dout.A = (const u16*)WSP(WS_ACT + 3 * SLOT); dout.Bt = (const u16*)WSP(WS_ML_OUT_T); dout.lda = 1024; dout.ldb = 1024; dout.K = 1024;
        }
        { dout.nM = nM; dout.nN = 4; dout.nZ = 1;
          Epi<M_RES> E{}; E.p.xsl = (l == 0) ? GF(I_X) : GF(I_OUT); E.p.xsc = (l == 0) ? GF(I_CTX) : (const float*)WSP(WS_XC); E.p.xdl = (float*)getp(lds, I_OUT); E.p.xdc = (float*)WSP(WS_XC);
          E.p.gate = (const float*)WSP(WS_MOD) + (size_t)l * 17 * 6144 + 2048;
          E.p.ng = GF(I_N2G) + l * 1024; E.p.nsc = (const float*)WSP(WS_MOD) + (size_t)l * 17 * 6144 + 4096; E.p.xb = (u16*)WSP(WS_ACT); E.p.rs = (float*)WSP(WS_RS);
          g8::gemm_phase(lds, dout, E, tacc, nkt); }
        SYNC(1);
#pragma unroll 1
        for (int part = 0; part < 2; ++part) {
            const int pn0 = part ? 11 : 0, nt = part ? 10 : 11;
            { g8::Desc d{}; d.A = (const u16*)WSP(WS_ACT); d.Bt = (const u16*)WSP(WS_FFN_UP_T + l * SZ_FFN_UP_T); d.lda = 1024; d.ldb = 1024; d.K = 1024; d.nM = nM; d.nN = nt; d.nZ = 1; d.pn0 = pn0; d.ablk = 1;
              Epi<M_BF16> E{}; E.p.o0 = (u16*)WSP(WS_ACT + SLOT); E.p.ldc = nt * 256; E.p.pn0 = pn0; E.p.rsr = (const float*)WSP(WS_RS); E.p.shw = (const float*)WSP(WS_SHW) + SHW_UP_OFF + (size_t)l * 17 * F2; E.p.shwld = F2;
              g8::gemm_phase(lds, d, E, tacc, nkt); }
            SYNC(1);
            phase_ffn_conv(lds, (const u16*)WSP(WS_ACT + SLOT), nt, pn0, GF(I_FCW) + (size_t)l * 9 * F2, GF(I_FCB) + (size_t)l * F2, (u16*)WSP(WS_ACT + SLOT + (size_t)MT * 2816 * 2), !last, tacc);
            SYNC(2);
        }
        { g8::Desc d{}; d.A = (const u16*)WSP(WS_ACT + SLOT + (size_t)MT * 2816 * 2); d.Bt = (const u16*)WSP(WS_FFN_DN_T + l * SZ_FFN_DN_T); d.lda = FH; d.ldb = FH; d.K = FH; d.nM = nM; d.nN = 4; d.nZ = 1;
          Epi<M_RES> E{}; E.p.xsl = GF(I_OUT); E.p.xsc = (const float*)WSP(WS_XC); E.p.xdl = (float*)getp(lds, I_OUT); E.p.xdc = (float*)WSP(WS_XC);
          E.p.gate = (const float*)WSP(WS_MOD) + (size_t)l * 17 * 6144 + 5120;
          if (!last) { E.p.ng = GF(I_N1G) + (l + 1) * 1024; E.p.nsc = (const float*)WSP(WS_MOD) + (size_t)(l + 1) * 17 * 6144 + 1024; E.p.xb = (u16*)WSP(WS_ACT); E.p.rs = (float*)WSP(WS_RS); }
          g8::gemm_phase(lds, d, E, tacc, nkt); }
        SYNC(1);
    }
    phase_final_norm((float*)getp(lds, I_OUT), GF(I_FNG));
    if (PROBE_CLASS == 17) { for (int i = 0; i < 100; ++i) grid.sync(); tacc = 0; }
    if (PROBE_CLASS == 9 || PROBE_CLASS == 11 || PROBE_CLASS == 12) tacc = nkt ? (tacc * 100ull) / nkt : 0ull;
    if (PROBE_CLASS == 10) tacc = cycacc / 20ull;
    if (PROBE_CLASS) { const unsigned long long tend = wall_clock64() + tacc; while (wall_clock64() < tend) __builtin_amdgcn_s_sleep(16); }
}

extern "C" void kernel_launch(void* const* d_in, const int* in_sizes, int n_in, void* d_out, int out_size, void* d_ws, size_t ws_size, hipStream_t stream) {
    static int grid = 0;
    if (grid == 0) {
        if (n_in != 33 || ws_size < WS_END) { fprintf(stderr, "kernel_launch: unexpected n_in %d or ws_size %zu (< %zu)\n", n_in, ws_size, (size_t)WS_END); grid = -1; return; }
        int dev = 0, cus = 0, per_cu = 0;
        hipGetDevice(&dev); hipDeviceGetAttribute(&cus, hipDeviceAttributeMultiprocessorCount, dev);
        if (hipFuncSetAttribute((const void*)mega_fwd, hipFuncAttributeMaxDynamicSharedMemorySize, LDS_BYTES) != hipSuccess) { fprintf(stderr, "kernel_launch: hipFuncSetAttribute failed\n"); grid = -1; return; }
        hipOccupancyMaxActiveBlocksPerMultiprocessor(&per_cu, (const void*)mega_fwd, 512, LDS_BYTES);
        (void)hipGetLastError();
        if (per_cu < 1) per_cu = 1;
        grid = cus * 1;
    }
    if (grid < 0) return;
    Params p{};
    const float** pp = (const float**)&p;
    for (int i = 0; i < 33; ++i) pp[i] = (const float*)d_in[i];
    p.out = (float*)d_out; p.ws = (unsigned char*)d_ws;
    (void)hipMemsetAsync((unsigned char*)d_ws + WS_BAR, 0, 16384, stream);
    void* args[] = {&p};
    hipError_t e = hipLaunchCooperativeKernel((const void*)mega_fwd, dim3(grid), dim3(512), args, LDS_BYTES, stream);
    if (e != hipSuccess) fprintf(stderr, "cooperative launch failed: %s (grid %d)\n", hipGetErrorString(e), grid);
}
```
